# Optimizing an MI355X kernel written in HIP

```python
import math
import jax
import jax.numpy as jnp
from jax import lax
import numpy as np

D_MODEL = 1024
BATCH = 8
SEQ = 4096
DEPTH = 2

HEAD_DIM = 64
N_MIXERS = 4
HEADS_PER_MIXER = D_MODEL // (N_MIXERS * HEAD_DIM)
MIX_WIDTH = N_MIXERS * HEADS_PER_MIXER * HEAD_DIM
A_HEADS = HEADS_PER_MIXER
DILATED_BRANCHES = ((128, 1), (512, 4), (2048, 16))
B_Q_HEADS = HEADS_PER_MIXER
B_KV_HEADS = HEADS_PER_MIXER // 2
B_GROUP = B_Q_HEADS // B_KV_HEADS
B_RADIUS = 128
C_HEADS = HEADS_PER_MIXER
C_QK_DIM = HEAD_DIM // 2
C_V_DIM = HEAD_DIM
D_HEADS = HEADS_PER_MIXER
D_Q_RANK = 3 * D_MODEL // 8
D_KV_RANK = D_MODEL // 8
D_NOPE_DIM = HEAD_DIM
D_ROPE_DIM = HEAD_DIM // 2
D_V_DIM = HEAD_DIM
ROPE_THETA = 10000.0
N_ALIBI_HEADS = A_HEADS + B_Q_HEADS + C_HEADS
QUERY_BLOCK = 128
D_FF = ((8 * D_MODEL + 767) // 768) * 256
A_IN = 3 * A_HEADS * HEAD_DIM
B_IN = (B_Q_HEADS + 2 * B_KV_HEADS) * HEAD_DIM
C_IN = C_HEADS * (4 * C_QK_DIM + C_V_DIM)
D_IN = D_Q_RANK + D_KV_RANK + D_ROPE_DIM
IN_WIDTH = A_IN + B_IN + C_IN + D_IN
IN_SPLITS = (A_IN, A_IN + B_IN, A_IN + B_IN + C_IN)
RMS_EPS = 1e-6
NEG_INF = -1e30
LAMBDA_STD = 0.1

kernel_name = 'hybrid_parallel_head_group_encoder'


def _rms_norm(x, g, eps=RMS_EPS):
    xf = x.astype(jnp.float32)
    y = xf * lax.rsqrt(jnp.mean(xf * xf, axis=-1, keepdims=True) + eps)
    return (y * g.astype(jnp.float32)).astype(x.dtype)


def _alibi_slopes():
    j = jnp.arange(1, N_ALIBI_HEADS + 1, dtype=jnp.float32)
    return jnp.exp2(-8.0 * j / N_ALIBI_HEADS)


def _rope_tables(pos):
    half = D_ROPE_DIM // 2
    inv = jnp.power(ROPE_THETA, -jnp.arange(half, dtype=jnp.float32) / half)
    ang = pos[..., None] * inv
    return jnp.cos(ang), jnp.sin(ang)


def _rope(x, cos, sin):
    half = x.shape[-1] // 2
    xf = x.astype(jnp.float32)
    x1, x2 = xf[..., :half], xf[..., half:]
    return jnp.concatenate([x1 * cos - x2 * sin, x1 * sin + x2 * cos], axis=-1).astype(x.dtype)


def _halo_blocks(a, axis, blk, nb):
    T = a.shape[axis]
    pad = [(0, 0)] * a.ndim
    pad[axis] = (blk, nb * blk - T + blk)
    ap = jnp.pad(a, pad)
    ap = ap.reshape(a.shape[:axis] + (nb + 2, blk) + a.shape[axis + 1:])
    prev = lax.slice_in_dim(ap, 0, nb, axis=axis)
    cur = lax.slice_in_dim(ap, 1, nb + 1, axis=axis)
    nxt = lax.slice_in_dim(ap, 2, nb + 2, axis=axis)
    return jnp.concatenate([prev, cur, nxt], axis=axis + 1)


def _banded_attention(q, k, v, pos, slope, radius, sink=None):
    bsz, G, R, T, Dk = q.shape
    W = radius
    nb = -(-T // W)
    qb = jnp.pad(q, ((0, 0), (0, 0), (0, 0), (0, nb * W - T), (0, 0))).reshape(bsz, G, R, nb, W, Dk)
    kb = _halo_blocks(k, 2, W, nb)
    vb = _halo_blocks(v, 2, W, nb)
    qp = jnp.pad(pos, ((0, 0), (0, nb * W - T))).reshape(bsz, nb, W)
    kp = _halo_blocks(pos, 1, W, nb)
    qi = jnp.arange(nb * W).reshape(nb, W)
    ki = (jnp.arange(nb)[:, None] - 1) * W + jnp.arange(3 * W)[None, :]
    valid = ((ki[:, None, :] >= 0) & (ki[:, None, :] < T)
             & (jnp.abs(qi[:, :, None] - ki[:, None, :]) <= radius))
    dist = jnp.abs(qp[:, :, :, None] - kp[:, :, None, :])
    s = jnp.einsum('bgrnqd,bgnkd->bgrnqk', qb, kb, preferred_element_type=jnp.float32)
    s = s - slope.astype(jnp.float32)[None, :, :, None, None, None] * dist[:, None, None]
    s = jnp.where(valid, s, NEG_INF)
    m = jnp.max(s, axis=-1)
    if sink is not None:
        sk = sink.astype(jnp.float32)[None, :, :, None, None]
        m = jnp.maximum(m, sk)
    p = jnp.exp(s - m[..., None])
    den = jnp.sum(p, axis=-1)
    if sink is not None:
        den = den + jnp.exp(sk - m)
    o = jnp.einsum('bgrnqk,bgnkd->bgrnqd', p.astype(v.dtype), vb,
                   preferred_element_type=jnp.float32) / den[..., None]
    lse = m + jnp.log(den)
    o = o.reshape(bsz, G, R, nb * W, -1)[:, :, :, :T]
    lse = lse.reshape(bsz, G, R, nb * W)[..., :T]
    return o, lse


def _dilated_mixture(q, k, v, pos, slopes):
    bsz, H, T, Dh = q.shape
    outs, lses = [], []
    for window, d in DILATED_BRANCHES:
        n = T // d

        def fold(a, d=d, n=n):
            return a.reshape(bsz, H, n, d, -1).transpose(0, 3, 1, 2, 4).reshape(bsz * d, H, n, a.shape[-1])

        pf = pos.reshape(bsz, n, d).transpose(0, 2, 1).reshape(bsz * d, n)
        o, lse = _banded_attention(fold(q)[:, :, None], fold(k), fold(v), pf,
                                   slopes[:, None], window // (2 * d))
        outs.append(o[:, :, 0].reshape(bsz, d, H, n, Dh).transpose(0, 2, 3, 1, 4).reshape(bsz, H, T, Dh))
        lses.append(lse[:, :, 0].reshape(bsz, d, H, n).transpose(0, 2, 3, 1).reshape(bsz, H, T))
    wts = jax.nn.softmax(jnp.stack(lses), axis=0)
    return jnp.einsum('ibht,ibhtd->bhtd', wts, jnp.stack(outs)).astype(q.dtype)


def _query_blocks(a):
    bsz, H, T, D = a.shape
    return a.reshape(bsz, H, T // QUERY_BLOCK, QUERY_BLOCK, D).transpose(2, 0, 1, 3, 4)


def _merge_query_blocks(o):
    nq, bsz, H, Q, D = o.shape
    return o.transpose(1, 2, 0, 3, 4).reshape(bsz, H, nq * Q, D)


def _diff_attention(q1, q2, k1, k2, v, pos, slopes, lam):
    bsz, H, T, _ = q1.shape
    pb = pos.reshape(bsz, T // QUERY_BLOCK, QUERY_BLOCK).transpose(1, 0, 2)

    def block(args):
        q1b, q2b, pq = args
        bias = -slopes[None, :, None, None] * jnp.abs(pq[:, None, :, None] - pos[:, None, None, :])
        a1 = jax.nn.softmax(jnp.einsum('bhqd,bhkd->bhqk', q1b, k1, preferred_element_type=jnp.float32) + bias, axis=-1)
        a2 = jax.nn.softmax(jnp.einsum('bhqd,bhkd->bhqk', q2b, k2, preferred_element_type=jnp.float32) + bias, axis=-1)
        return jnp.einsum('bhqk,bhkd->bhqd', (a1 - lam * a2).astype(v.dtype), v,
                          preferred_element_type=jnp.float32)

    return _merge_query_blocks(lax.map(block, (_query_blocks(q1), _query_blocks(q2), pb)))


def _mla_attention(q_nope, q_rope, k_nope, k_rope, v):
    def block(args):
        qn, qr = args
        s = (jnp.einsum('bhqd,bhkd->bhqk', qn, k_nope, preferred_element_type=jnp.float32)
             + jnp.einsum('bhqd,bkd->bhqk', qr, k_rope, preferred_element_type=jnp.float32))
        p = jax.nn.softmax(s, axis=-1)
        return jnp.einsum('bhqk,bhkd->bhqd', p.astype(v.dtype), v, preferred_element_type=jnp.float32)

    return _merge_query_blocks(lax.map(block, (_query_blocks(q_nope), _query_blocks(q_rope))))


def _hybrid_token_mixer(h, pos, cos, sin, layer, w_in, sink, lq1, lk1, lq2, lk2,
                        g_diff, g_q, g_kv, w_uq, w_ukv, w_out):
    bsz, T, _ = h.shape
    slopes = _alibi_slopes()
    sl_b = slopes[:B_Q_HEADS]
    sl_c = slopes[B_Q_HEADS:B_Q_HEADS + C_HEADS]
    sl_a = slopes[B_Q_HEADS + C_HEADS:]
    z = jnp.einsum('btd,de->bte', h, w_in)
    z_a, z_b, z_c, z_d = jnp.split(z, IN_SPLITS, axis=-1)

    qa, ka, va = [t.reshape(bsz, T, A_HEADS, HEAD_DIM).transpose(0, 2, 1, 3)
                  for t in jnp.split(z_a, 3, axis=-1)]
    o_a = _dilated_mixture(qa * HEAD_DIM ** -0.5, ka, va, pos, sl_a)
    o_a = o_a.transpose(0, 2, 1, 3).reshape(bsz, T, A_HEADS * HEAD_DIM)

    qb, kb, vb = jnp.split(z_b, (B_Q_HEADS * HEAD_DIM, (B_Q_HEADS + B_KV_HEADS) * HEAD_DIM), axis=-1)
    qb = qb.reshape(bsz, T, B_KV_HEADS, B_GROUP, HEAD_DIM).transpose(0, 2, 3, 1, 4) * HEAD_DIM ** -0.5
    kb = kb.reshape(bsz, T, B_KV_HEADS, HEAD_DIM).transpose(0, 2, 1, 3)
    vb = vb.reshape(bsz, T, B_KV_HEADS, HEAD_DIM).transpose(0, 2, 1, 3)
    o_b, _ = _banded_attention(qb, kb, vb, pos, sl_b.reshape(B_KV_HEADS, B_GROUP), B_RADIUS,
                               sink.reshape(B_KV_HEADS, B_GROUP))
    o_b = o_b.transpose(0, 3, 1, 2, 4).reshape(bsz, T, B_Q_HEADS * HEAD_DIM).astype(h.dtype)

    qc, kc, vc = jnp.split(z_c, (C_HEADS * 2 * C_QK_DIM, C_HEADS * 4 * C_QK_DIM), axis=-1)
    qc = qc.reshape(bsz, T, C_HEADS, 2, C_QK_DIM).transpose(3, 0, 2, 1, 4) * C_QK_DIM ** -0.5
    kc = kc.reshape(bsz, T, C_HEADS, 2, C_QK_DIM).transpose(3, 0, 2, 1, 4)
    vc = vc.reshape(bsz, T, C_HEADS, C_V_DIM).transpose(0, 2, 1, 3)
    lam_init = 0.8 - 0.6 * math.exp(-0.3 * layer)
    f32 = jnp.float32
    lam = (jnp.exp(jnp.sum(lq1.astype(f32) * lk1.astype(f32)))
           - jnp.exp(jnp.sum(lq2.astype(f32) * lk2.astype(f32))) + lam_init)
    o_c = _diff_attention(qc[0], qc[1], kc[0], kc[1], vc, pos, sl_c, lam)
    o_c = _rms_norm(o_c, g_diff) * (1.0 - lam_init)
    o_c = o_c.transpose(0, 2, 1, 3).reshape(bsz, T, C_HEADS * C_V_DIM).astype(h.dtype)

    cq, ckv, kr = jnp.split(z_d, (D_Q_RANK, D_Q_RANK + D_KV_RANK), axis=-1)
    qd = jnp.einsum('btr,re->bte', _rms_norm(cq, g_q), w_uq).reshape(bsz, T, D_HEADS, D_NOPE_DIM + D_ROPE_DIM)
    q_nope = qd[..., :D_NOPE_DIM]
    q_rope = _rope(qd[..., D_NOPE_DIM:], cos[:, :, None], sin[:, :, None])
    kv = jnp.einsum('btr,re->bte', _rms_norm(ckv, g_kv), w_ukv).reshape(bsz, T, D_HEADS, D_NOPE_DIM + D_V_DIM)
    k_nope, v_d = kv[..., :D_NOPE_DIM], kv[..., D_NOPE_DIM:]
    k_rope = _rope(kr, cos, sin)
    d_scale = (D_NOPE_DIM + D_ROPE_DIM) ** -0.5
    o_d = _mla_attention(q_nope.transpose(0, 2, 1, 3) * d_scale, q_rope.transpose(0, 2, 1, 3) * d_scale,
                         k_nope.transpose(0, 2, 1, 3), k_rope, v_d.transpose(0, 2, 1, 3))
    o_d = o_d.transpose(0, 2, 1, 3).reshape(bsz, T, D_HEADS * D_V_DIM).astype(h.dtype)

    mix = jnp.concatenate([o_a, o_b, o_c, o_d], axis=-1)
    return jnp.einsum('btm,md->btd', mix, w_out)


def _swiglu(h, w_gate_up, w_down):
    g, u = jnp.split(jnp.einsum('btd,df->btf', h, w_gate_up), 2, axis=-1)
    return jnp.einsum('btf,fd->btd', jax.nn.silu(g) * u, w_down)


def setup_inputs(seed: int = 0) -> dict:
    key = jax.random.key(seed)
    ks = jax.random.split(key, 23)
    L, D = DEPTH, D_MODEL
    f32 = jnp.float32

    def dense(k, shape, fan_in, gain=1.0):
        return gain * fan_in ** -0.5 * jax.random.normal(k, shape, f32)

    def norm_gain(k, n):
        return 1.0 + 0.05 * jax.random.normal(k, (L, n), f32)

    return {
        'x': jax.random.normal(ks[0], (BATCH, SEQ, D), f32),
        'c': jax.random.normal(ks[1], (BATCH, D), f32),
        'positions': (jax.random.randint(ks[2], (BATCH, 1), 0, SEQ, dtype=jnp.int32)
                      + jnp.arange(SEQ, dtype=jnp.int32)[None, :]),
        'w_ada': dense(ks[3], (L, D, 6 * D), D, 0.5),
        'b_ada': 0.01 * jax.random.normal(ks[4], (L, 6 * D), f32),
        'g_pre_mix': norm_gain(ks[5], D),
        'g_post_mix': norm_gain(ks[6], D),
        'w_in': dense(ks[7], (L, D, IN_WIDTH), D),
        'sink_logits': 0.5 * jax.random.normal(ks[8], (L, B_Q_HEADS), f32),
        'lam_q1': LAMBDA_STD * jax.random.normal(ks[9], (L, C_QK_DIM), f32),
        'lam_k1': LAMBDA_STD * jax.random.normal(ks[10], (L, C_QK_DIM), f32),
        'lam_q2': LAMBDA_STD * jax.random.normal(ks[11], (L, C_QK_DIM), f32),
        'lam_k2': LAMBDA_STD * jax.random.normal(ks[12], (L, C_QK_DIM), f32),
        'g_diff': norm_gain(ks[13], C_V_DIM),
        'g_mla_q': norm_gain(ks[14], D_Q_RANK),
        'g_mla_kv': norm_gain(ks[15], D_KV_RANK),
        'w_uq': dense(ks[16], (L, D_Q_RANK, D_HEADS * (D_NOPE_DIM + D_ROPE_DIM)), D_Q_RANK),
        'w_ukv': dense(ks[17], (L, D_KV_RANK, D_HEADS * (D_NOPE_DIM + D_V_DIM)), D_KV_RANK),
        'w_out': dense(ks[18], (L, MIX_WIDTH, D), MIX_WIDTH),
        'g_pre_ffn': norm_gain(ks[19], D),
        'g_post_ffn': norm_gain(ks[20], D),
        'w_gate_up': dense(ks[21], (L, D, 2 * D_FF), D),
        'w_down': dense(ks[22], (L, D_FF, D), D_FF),
    }


def reference(x, c, positions, w_ada, b_ada, g_pre_mix, g_post_mix, w_in, sink_logits,
              lam_q1, lam_k1, lam_q2, lam_k2, g_diff, g_mla_q, g_mla_kv, w_uq, w_ukv,
              w_out, g_pre_ffn, g_post_ffn, w_gate_up, w_down):
    pos = positions.astype(jnp.float32)
    cos, sin = _rope_tables(pos)
    c_act = jax.nn.silu(c)
    for layer in range(DEPTH):
        mod = jnp.einsum('bd,de->be', c_act, w_ada[layer]) + b_ada[layer]
        sh_m, sc_m, gt_m, sh_f, sc_f, gt_f = [m[:, None, :] for m in jnp.split(mod, 6, axis=-1)]
        h = _rms_norm(x, g_pre_mix[layer]) * (1.0 + sc_m) + sh_m
        mix = _hybrid_token_mixer(h, pos, cos, sin, layer, w_in[layer], sink_logits[layer],
                                  lam_q1[layer], lam_k1[layer], lam_q2[layer], lam_k2[layer],
                                  g_diff[layer], g_mla_q[layer], g_mla_kv[layer],
                                  w_uq[layer], w_ukv[layer], w_out[layer])
        x = x + gt_m * _rms_norm(mix, g_post_mix[layer])
        h = _rms_norm(x, g_pre_ffn[layer]) * (1.0 + sc_f) + sh_f
        x = x + gt_f * _rms_norm(_swiglu(h, w_gate_up[layer], w_down[layer]), g_post_ffn[layer])
    return x
```

```cpp
#include <hip/hip_runtime.h>
#include <cstdio>
#include <cstdint>

typedef unsigned short bf16_t;
typedef unsigned u32x4 __attribute__((ext_vector_type(4)));
typedef float f32x4 __attribute__((ext_vector_type(4)));

constexpr int BATCH = 8, SEQ = 4096, DM = 1024, DEPTH = 2, M = BATCH * SEQ;
constexpr int IN_W = 2592, NZ = 2816, DFF = 2816, NGU = 5632;
constexpr int NUP = 1024, KUP = 512;
constexpr float RMS_EPS = 1e-6f;
constexpr float LOG2E = 1.4426950408889634f;
constexpr int ZA_Q = 0, ZA_K = 256, ZA_V = 512, ZB_Q = 768, ZB_K = 1024, ZB_V = 1152, ZC_Q = 1280, ZC_K = 1536, ZC_V = 1792, ZD_CQ = 2048, ZD_CKV = 2432, ZD_KR = 2560;

constexpr size_t MiB = 1u << 20;
constexpr size_t WS_CTL = 0;
constexpr size_t WS_MOD = 1 * MiB;
constexpr size_t WS_COS = 2 * MiB, WS_SIN = 4 * MiB;
constexpr size_t WS_SS = 6 * MiB;
constexpr size_t WS_YSS = 8 * MiB;
constexpr size_t WS_LSE = 10 * MiB;
constexpr size_t WS_POSF = 1 * MiB + 512 * 1024;
constexpr size_t WS_PMM = 11 * MiB + 512 * 1024;
constexpr size_t WS_W = 12 * MiB;
constexpr size_t W_IN = 0, W_UP = 5632 * 1024, W_OUT = W_UP + 1 * MiB, W_GU = W_OUT + 2 * MiB, W_DN = W_GU + 11 * MiB, W_LAYER = 25 * MiB;
constexpr size_t WS_XN = 62 * MiB;
constexpr size_t WS_ZH = 126 * MiB;
constexpr size_t WS_KV = 302 * MiB;
constexpr size_t WS_QD = 334 * MiB;
constexpr size_t WS_MIX = 358 * MiB;
constexpr size_t WS_Y = 422 * MiB;
constexpr size_t WS_END = 486 * MiB;

__device__ __forceinline__ float bf2f(bf16_t v) { return __uint_as_float(((unsigned)v) << 16); }
__device__ __forceinline__ bf16_t f2bf(float f) { unsigned u = __float_as_uint(f); return (bf16_t)((u + 0x7fffu + ((u >> 16) & 1u)) >> 16); }
__device__ __forceinline__ float wave_sum(float v) {
#pragma unroll
    for (int o = 1; o < 64; o <<= 1) v += __shfl_xor(v, o);
    return v;
}
__host__ __device__ __forceinline__ float alibi_slope(int j  ) { return exp2f(-8.0f * (float)j / 12.0f); }

struct ElemArgs { const float* xin; float* xout; const bf16_t* Y; const float* YSS; const float* gpost; const float* modg; int gate_chunk; const float* gpre; const float* modn; int sc_chunk, sh_chunk; bf16_t* XN; int do_res, do_norm; };

#define LAS __attribute__((address_space(3)))
typedef short bf16x8 __attribute__((ext_vector_type(8)));
typedef float f32x16 __attribute__((ext_vector_type(16)));
typedef float f32x2 __attribute__((ext_vector_type(2)));
typedef int i32x4 __attribute__((ext_vector_type(4)));
typedef __bf16 bf16x2_t __attribute__((ext_vector_type(2)));
typedef short s16x4 __attribute__((ext_vector_type(4)));
__device__ __forceinline__ unsigned cvtpk(float lo, float hi) { f32x2 v = {lo, hi}; bf16x2_t b = __builtin_convertvector(v, bf16x2_t); return __builtin_bit_cast(unsigned, b); }
__device__ __forceinline__ u32x4 pack8(const f32x4& a, const f32x4& b) { u32x4 w; w.x = cvtpk(a[0], a[1]); w.y = cvtpk(a[2], a[3]); w.z = cvtpk(b[0], b[1]); w.w = cvtpk(b[2], b[3]); return w; }

namespace pg8 {
constexpr int BM = 256, BK = 64, HALF = 128, HTB = HALF * BK * 2, STAGE_BYTES = 8 * HTB, NXCD = 8, WGM = 8;
__host__ __device__ __forceinline__ int lds_byte(int r, int c) { const int st = (r >> 4) * 2 + (c >> 5), rr = r & 15, cc = c & 31, ob = rr * 64 + cc * 2; return st * 1024 + (ob ^ (((ob >> 9) & 1) << 5)); }
__host__ __device__ __forceinline__ void stage_rc(int b, int& R, int& C) { const int st = b / 1024, sb = b % 1024, swz = sb ^ (((sb >> 9) & 1) << 5); R = (st >> 1) * 16 + swz / 64; C = (st & 1) * 32 + (swz % 64) / 2; }
__host__ __device__ __forceinline__ int perm32(int rho) { const int n = rho >> 4, i = rho & 15; return 8 * (i >> 2) + 4 * n + (i & 3); }
struct Unit { int pm, pn; };
struct Gemm { const bf16_t* A; const bf16_t* Bt; int M, N, K, lda, ksplit; };
struct StaticOrder {
    int nM, nN, nwg, G, c;
    __device__ void init(int M_, int N_, int G_, int c_) { nM = M_ / BM; nN = N_ / BM; nwg = nM * nN; G = G_; c = c_; }
    __device__ bool next(int i, Unit& u) const {
        const long L = (long)i * G + c; if (L >= nwg) return false;
        int wgid = (int)L; { const int q = nwg / NXCD, r = nwg % NXCD, xcd = wgid % NXCD, off = wgid / NXCD; wgid = (xcd < r ? xcd * (q + 1) : r * (q + 1) + (xcd - r) * q) + off; }
        const int nig = WGM * nN, gid = wgid / nig, fm = gid * WGM, gsz = (nM - fm) < WGM ? (nM - fm) : WGM;
        u.pm = fm + ((wgid % nig) % gsz); u.pn = (wgid % nig) / gsz; return true;
    }
};
template <class Epi, bool ALIGN_EPI>
__device__ __forceinline__ void gemm_phase(LAS unsigned char* lds, const Gemm g, const StaticOrder& S, const Epi& E, const int tid) {
    const int wid = __builtin_amdgcn_readfirstlane(tid >> 6), lane = tid & 63, wr = wid >> 2, wc = wid & 3, fr = lane & 15, fq = lane >> 4;
    const int K = g.K, lda = g.lda; int nt = K / BK;
    unsigned voffA[2], voffB[2];
#pragma unroll
    for (int i = 0; i < 2; ++i) { int R, C; stage_rc(tid * 16 + i * 8192, R, C); const int Rb = (R & ~31) + perm32(R & 31);
        voffA[i] = (unsigned)(R * lda + C) * 2u; voffB[i] = (unsigned)(Rb * K + C) * 2u; }
    const size_t kstep = (size_t)(BK * 2);
    const size_t hstepA = (size_t)HALF * lda * 2, hstepB = (size_t)HALF * K * 2, tstepA = 2 * hstepA, tstepB = 2 * hstepB;
    const unsigned ldsw = (unsigned)wid * 1024u;
    const int aoff = lds_byte(wr * 64 + fr, fq * 8), boff = lds_byte(wc * 32 + fr, fq * 8);
#define PG8_SA(b, h) (((b) * 2 + (h)) * HTB)
#define PG8_SB(b, h) ((4 + (b) * 2 + (h)) * HTB)
#define PG8_STAGE(bufoff, gbase, voff) do { _Pragma("unroll") for (int _i = 0; _i < 2; ++_i) \
        __builtin_amdgcn_global_load_lds((const unsigned*)((const char*)(gbase) + (voff)[_i]), (LAS unsigned*)(lds + (bufoff) + ldsw + _i * 8192), 16, 0, 0); } while (0)
#define PG8_LDA(dst, b, h) do { _Pragma("unroll") for (int m = 0; m < 4; ++m) _Pragma("unroll") for (int k = 0; k < 2; ++k) dst[m][k] = *(const LAS bf16x8*)(lds + PG8_SA(b, h) + aoff + m * 2048 + k * 1024); } while (0)
#define PG8_LDB(dst, b, h) do { _Pragma("unroll") for (int n = 0; n < 2; ++n) _Pragma("unroll") for (int k = 0; k < 2; ++k) dst[n][k] = *(const LAS bf16x8*)(lds + PG8_SB(b, h) + boff + n * 2048 + k * 1024); } while (0)
#define PG8_MMA(ai, bj, At, Bt) do { __builtin_amdgcn_s_setprio(1); _Pragma("unroll") for (int m = 0; m < 4; ++m) _Pragma("unroll") for (int n = 0; n < 2; ++n) _Pragma("unroll") for (int k = 0; k < 2; ++k) \
        acc[ai][bj][m][n] = __builtin_amdgcn_mfma_f32_16x16x32_bf16(Bt[n][k], At[m][k], acc[ai][bj][m][n], 0, 0, 0); __builtin_amdgcn_s_setprio(0); } while (0)
#define PG8_WAIT_V(n) asm volatile("s_waitcnt vmcnt(" #n ")" ::: "memory")
#define PG8_WAIT_L(n) asm volatile("s_waitcnt lgkmcnt(" #n ")" ::: "memory")
#define PG8_BAR __builtin_amdgcn_s_barrier()
#define PG8_SCHED __builtin_amdgcn_sched_barrier(0)
    Unit cur, nxt; int ui = 0;
    if (!S.next(0, cur)) return;
    f32x4 acc[2][2][4][2];
#pragma unroll
    for (int a = 0; a < 2; ++a)
#pragma unroll
        for (int b = 0; b < 2; ++b)
#pragma unroll
            for (int m = 0; m < 4; ++m)
#pragma unroll
                for (int n = 0; n < 2; ++n) acc[a][b][m][n] = (f32x4){0.f, 0.f, 0.f, 0.f};
    bf16x8 At[4][2], B0[2][2], B1[2][2];
#define PG8_KBEG(u_) (g.ksplit ? ((u_).pn < 2 ? 512 : 0) : 0)
#define PG8_KNT(u_) (g.ksplit ? ((u_).pn < 2 ? 4 : 6) : K / BK)
    const char* cA = (const char*)g.A + (size_t)cur.pm * tstepA + PG8_KBEG(cur); const char* cB = (const char*)g.Bt + (size_t)cur.pn * tstepB + PG8_KBEG(cur); nt = PG8_KNT(cur);
    PG8_STAGE(PG8_SB(0, 0), cB, voffB); PG8_STAGE(PG8_SB(0, 1), cB + hstepB, voffB); PG8_STAGE(PG8_SA(0, 0), cA, voffA); PG8_STAGE(PG8_SA(0, 1), cA + hstepA, voffA);
    if (wr == 1) PG8_BAR;
    PG8_WAIT_V(2); PG8_BAR;
    PG8_STAGE(PG8_SB(1, 0), cB + kstep, voffB); PG8_STAGE(PG8_SA(1, 0), cA + kstep, voffA); PG8_STAGE(PG8_SB(1, 1), cB + hstepB + kstep, voffB);
    PG8_WAIT_V(6); PG8_BAR;
    for (;;) {
        const bool has_next = S.next(ui + 1, nxt);
        const char* nA = has_next ? (const char*)g.A + (size_t)nxt.pm * tstepA + PG8_KBEG(nxt) : cA; const char* nB = has_next ? (const char*)g.Bt + (size_t)nxt.pn * tstepB + PG8_KBEG(nxt) : cB;
        for (int t = 0; t < nt; t += 2) {
            const bool last = (t == nt - 2);
            const char* a1 = cA + (size_t)(t + 1) * kstep;
            const char* a2 = last ? nA : cA + (size_t)(t + 2) * kstep; const char* b2 = last ? nB : cB + (size_t)(t + 2) * kstep;
            const char* a3 = a2 + kstep; const char* b3 = b2 + kstep;
            PG8_LDB(B0, 0, 0); PG8_LDB(B1, 0, 1); PG8_SCHED; PG8_LDA(At, 0, 0); PG8_STAGE(PG8_SA(1, 1), a1 + hstepA, voffA);
            PG8_WAIT_V(8); PG8_WAIT_L(0); PG8_BAR; PG8_MMA(0, 0, At, B0); PG8_MMA(0, 1, At, B1); PG8_BAR; PG8_SCHED;
            PG8_LDA(At, 0, 1); PG8_STAGE(PG8_SB(0, 0), b2, voffB); PG8_STAGE(PG8_SB(0, 1), b2 + hstepB, voffB); PG8_STAGE(PG8_SA(0, 0), a2, voffA);
            PG8_WAIT_V(8); PG8_WAIT_L(0); PG8_BAR; PG8_MMA(1, 0, At, B0); PG8_MMA(1, 1, At, B1); PG8_BAR; PG8_SCHED;
            PG8_LDB(B0, 1, 0); PG8_LDB(B1, 1, 1); PG8_SCHED; PG8_LDA(At, 1, 0); PG8_STAGE(PG8_SA(0, 1), a2 + hstepA, voffA);
            PG8_WAIT_V(8); PG8_WAIT_L(0); PG8_BAR; PG8_MMA(0, 0, At, B0); PG8_MMA(0, 1, At, B1); PG8_BAR; PG8_SCHED;
            PG8_LDA(At, 1, 1); PG8_STAGE(PG8_SB(1, 0), b3, voffB); PG8_STAGE(PG8_SB(1, 1), b3 + hstepB, voffB); PG8_STAGE(PG8_SA(1, 0), a3, voffA);
            PG8_WAIT_V(8); PG8_WAIT_L(0); PG8_BAR; PG8_MMA(1, 0, At, B0); PG8_MMA(1, 1, At, B1); PG8_BAR; PG8_SCHED;
        }
        if constexpr (ALIGN_EPI) { if (wr == 0) PG8_BAR; }
        if constexpr (Epi::FUSED) E.fused(acc, cur, wr, wc, fr, fq, lds, wid, lane, tid); else E(acc, cur, wr, wc, fr, fq);
        if (!has_next) break;
#pragma unroll
        for (int a = 0; a < 2; ++a)
#pragma unroll
            for (int b = 0; b < 2; ++b)
#pragma unroll
                for (int m = 0; m < 4; ++m)
#pragma unroll
                    for (int n = 0; n < 2; ++n) acc[a][b][m][n] = (f32x4){0.f, 0.f, 0.f, 0.f};
        cur = nxt; cA = nA; cB = nB; ++ui; nt = PG8_KNT(cur);
        if constexpr (ALIGN_EPI) { if (wr == 1) PG8_BAR; }
    }
    PG8_WAIT_V(0);
    if constexpr (!ALIGN_EPI) { if (wr == 0) PG8_BAR; }
    PG8_BAR;
#undef PG8_KBEG
#undef PG8_KNT
#undef PG8_SA
#undef PG8_SB
#undef PG8_STAGE
#undef PG8_LDA
#undef PG8_LDB
#undef PG8_MMA
#undef PG8_WAIT_V
#undef PG8_WAIT_L
#undef PG8_BAR
#undef PG8_SCHED
}
}

__device__ __forceinline__ float sumsq8(const f32x4& a, const f32x4& b) { return ((a[0] * a[0] + a[1] * a[1]) + (a[2] * a[2] + a[3] * a[3])) + ((b[0] * b[0] + b[1] * b[1]) + (b[2] * b[2] + b[3] * b[3])); }
__device__ __forceinline__ void rope8(f32x4& v0, f32x4& v1, const float* cosr, const float* sinr, int fq) {
    const int i0 = 8 * (fq & 1);
    const f32x4 c0 = *(const f32x4*)(cosr + i0), c1 = *(const f32x4*)(cosr + i0 + 4), s0 = *(const f32x4*)(sinr + i0), s1 = *(const f32x4*)(sinr + i0 + 4);
    f32x4 p0, p1;
#pragma unroll
    for (int e = 0; e < 4; ++e) { p0[e] = __shfl_xor(v0[e], 32); p1[e] = __shfl_xor(v1[e], 32); }
    if (fq < 2) { v0 = v0 * c0 - p0 * s0; v1 = v1 * c1 - p1 * s1; }
    else        { v0 = p0 * s0 + v0 * c0; v1 = p1 * s1 + v1 * c1; }
}
struct EpiZ {
    static constexpr bool FUSED = false;
    bf16_t* Z; float* SS; const float* cosT; const float* sinT; unsigned* KMAX; int pn_off;
    __device__ __forceinline__ void operator()(const f32x4 (&acc)[2][2][4][2], const pg8::Unit& u_, int wr, int wc, int fr, int fq) const {
        pg8::Unit u = u_; u.pn += pn_off;
        const int row0 = u.pm * 256 + wr * 64 + fr, colb = u.pn * 256 + wc * 32 + 8 * fq;
        const bool rope = (u.pn == 10) && (wc == 0), ssq = (u.pn == 8) || (u.pn == 9);
#pragma unroll
        for (int ai = 0; ai < 2; ++ai)
#pragma unroll
            for (int m = 0; m < 4; ++m) { const int row = row0 + ai * 128 + m * 16;
                f32x4 a0 = acc[ai][0][m][0], a1 = acc[ai][0][m][1]; const f32x4 b0 = acc[ai][1][m][0], b1 = acc[ai][1][m][1];
                if (rope) rope8(a0, a1, cosT + (size_t)row * 16, sinT + (size_t)row * 16, fq);
                *(u32x4*)(Z + (size_t)row * NZ + colb) = pack8(a0, a1);
                *(u32x4*)(Z + (size_t)row * NZ + colb + 128) = pack8(b0, b1);
                if (ssq) { float s0 = sumsq8(a0, a1), s1 = sumsq8(b0, b1);
                    s0 += __shfl_xor(s0, 16); s0 += __shfl_xor(s0, 32); s1 += __shfl_xor(s1, 16); s1 += __shfl_xor(s1, 32);
                    if (fq == 0) { if (u.pn == 8) SS[(size_t)row * 12 + wc] = s0 + s1; else { SS[(size_t)row * 12 + 4 + wc] = s0; SS[(size_t)row * 12 + 8 + wc] = s1; } } }
                asm volatile("" ::: "memory");
            }
        if (u.pn == 6) {
            float mx0 = 0.f, mx1 = 0.f;
#pragma unroll
            for (int ai = 0; ai < 2; ++ai)
#pragma unroll
                for (int m = 0; m < 4; ++m) { float s0 = sumsq8(acc[ai][0][m][0], acc[ai][0][m][1]), s1 = sumsq8(acc[ai][1][m][0], acc[ai][1][m][1]);
                    s0 += __shfl_xor(s0, 16); s0 += __shfl_xor(s0, 32); s1 += __shfl_xor(s1, 16); s1 += __shfl_xor(s1, 32); mx0 = fmaxf(mx0, s0); mx1 = fmaxf(mx1, s1); }
#pragma unroll
            for (int o_ = 1; o_ < 16; o_ <<= 1) { mx0 = fmaxf(mx0, __shfl_xor(mx0, o_)); mx1 = fmaxf(mx1, __shfl_xor(mx1, o_)); }
            if (fr == 0 && fq == 0) { const int b = (u.pm * 256) / SEQ;
                atomicMax(KMAX + (b * 4 + (wc >> 1)) * 2 + (wc & 1), __float_as_uint(mx0)); atomicMax(KMAX + (b * 4 + 2 + (wc >> 1)) * 2 + (wc & 1), __float_as_uint(mx1)); }
        }
    }
};
struct EpiUp {
    static constexpr bool FUSED = false;
    bf16_t* KV; bf16_t* QD; const float* SS; const float* cosT; const float* sinT;
    __device__ __forceinline__ void operator()(const f32x4 (&acc)[2][2][4][2], const pg8::Unit& u, int wr, int wc, int fr, int fq) const {
        const int row0 = u.pm * 256 + wr * 64 + fr;
#pragma unroll
        for (int ai = 0; ai < 2; ++ai)
#pragma unroll
            for (int m = 0; m < 4; ++m) { const int row = row0 + ai * 128 + m * 16;
                const f32x4 sa = *(const f32x4*)(SS + (size_t)row * 12), sb = *(const f32x4*)(SS + (size_t)row * 12 + 4), sc = *(const f32x4*)(SS + (size_t)row * 12 + 8);
                if (u.pn < 2) {
                    const float rs = rsqrtf(((sc[0] + sc[1]) + (sc[2] + sc[3])) * (1.f / 128.f) + RMS_EPS);
#pragma unroll
                    for (int bj = 0; bj < 2; ++bj) *(u32x4*)(KV + (size_t)row * 512 + 256 * u.pn + 128 * bj + 32 * wc + 8 * fq) = pack8(acc[ai][bj][m][0] * rs, acc[ai][bj][m][1] * rs);
                } else {
                    const float rs = rsqrtf((((sa[0] + sa[1]) + (sa[2] + sa[3])) + ((sb[0] + sb[1]) + (sb[2] + sb[3]))) * (1.f / 384.f) + RMS_EPS);
#pragma unroll
                    for (int bj = 0; bj < 2; ++bj) { if (u.pn == 3 && bj == 1) continue;
                        const int c0 = 256 * (u.pn - 2) + 128 * bj + 32 * wc;
                        f32x4 v0 = acc[ai][bj][m][0] * rs, v1 = acc[ai][bj][m][1] * rs;
                        if ((c0 % 96) == 64) rope8(v0, v1, cosT + (size_t)row * 16, sinT + (size_t)row * 16, fq);
                        *(u32x4*)(QD + (size_t)row * 384 + c0 + 8 * fq) = pack8(v0, v1); }
                }
                asm volatile("" ::: "memory");
            }
    }
};
struct EpiY {
    static constexpr bool FUSED = false;
    bf16_t* Y; float* YSS;
    __device__ __forceinline__ void operator()(const f32x4 (&acc)[2][2][4][2], const pg8::Unit& u, int wr, int wc, int fr, int fq) const {
        const int row0 = u.pm * 256 + wr * 64 + fr, colb = u.pn * 256 + wc * 32 + 8 * fq;
#pragma unroll
        for (int ai = 0; ai < 2; ++ai)
#pragma unroll
            for (int m = 0; m < 4; ++m) { const int row = row0 + ai * 128 + m * 16;
                *(u32x4*)(Y + (size_t)row * DM + colb) = pack8(acc[ai][0][m][0], acc[ai][0][m][1]);
                *(u32x4*)(Y + (size_t)row * DM + colb + 128) = pack8(acc[ai][1][m][0], acc[ai][1][m][1]);
                float s = sumsq8(acc[ai][0][m][0], acc[ai][0][m][1]) + sumsq8(acc[ai][1][m][0], acc[ai][1][m][1]);
                s += __shfl_xor(s, 16); s += __shfl_xor(s, 32);
                if (fq == 0) YSS[(size_t)row * 16 + 4 * u.pn + wc] = s; }
    }
};
__device__ __forceinline__ float silu_mul(float g, float u) { return g * __builtin_amdgcn_rcpf(1.f + __builtin_amdgcn_exp2f(-g * LOG2E)) * u; }
struct EpiH {
    static constexpr bool FUSED = false;
    bf16_t* H;
    __device__ __forceinline__ void operator()(const f32x4 (&acc)[2][2][4][2], const pg8::Unit& u, int wr, int wc, int fr, int fq) const {
        const int row0 = u.pm * 256 + wr * 64 + fr, colb = u.pn * 128 + wc * 32 + 8 * fq;
#pragma unroll
        for (int ai = 0; ai < 2; ++ai)
#pragma unroll
            for (int m = 0; m < 4; ++m) { const int row = row0 + ai * 128 + m * 16; f32x4 h0, h1;
#pragma unroll
                for (int e = 0; e < 4; ++e) { h0[e] = silu_mul(acc[ai][0][m][0][e], acc[ai][1][m][0][e]); h1[e] = silu_mul(acc[ai][0][m][1][e], acc[ai][1][m][1][e]); }
                *(u32x4*)(H + (size_t)row * DFF + colb) = pack8(h0, h1); }
    }
};

constexpr int TAB_OFF = 131072 + 1024;
struct RowStat {
    unsigned* slot; unsigned* cnt;
    __device__ __forceinline__ void run(const float (&part)[8], const pg8::Unit& u, int wr, int wc, int fr, int fq, LAS unsigned char* lds, int wid, int lane, int tid_) const {
        int tid = tid_; asm volatile("" : "+v"(tid));
        LAS float* P = (LAS float*)(lds + TAB_OFF); LAS float* S = (LAS float*)(lds + TAB_OFF + 4096);
#pragma unroll
        for (int i = 0; i < 8; ++i) { float v = part[i]; v += __shfl_xor(v, 16); v += __shfl_xor(v, 32); if (fq == 0) P[((i >> 2) * 128 + wr * 64 + (i & 3) * 16 + fr) * 4 + wc] = v; }
        asm volatile("s_waitcnt lgkmcnt(0)" ::: "memory"); __builtin_amdgcn_s_barrier(); asm volatile("" ::: "memory");
        if (wid < 4) {
            const f32x4 p4 = *(const LAS f32x4*)(P + tid * 4);
            __hip_atomic_store(slot + ((size_t)(u.pm * 256 + tid)) * 4 + u.pn, __float_as_uint((p4[0] + p4[1]) + (p4[2] + p4[3])), __ATOMIC_RELAXED, __HIP_MEMORY_SCOPE_AGENT);
            asm volatile("s_waitcnt vmcnt(0)" ::: "memory");
            if (lane == 0) __hip_atomic_fetch_add(cnt + 64 * u.pm, 1u, __ATOMIC_RELAXED, __HIP_MEMORY_SCOPE_AGENT);
        }
        if (wid == 0) {
            unsigned spins = 0;
            while ((unsigned)__builtin_amdgcn_readfirstlane(__hip_atomic_load(cnt + 64 * u.pm, __ATOMIC_RELAXED, __HIP_MEMORY_SCOPE_AGENT)) < 16u) { __builtin_amdgcn_s_sleep(2); if (++spins > (1u << 20)) break; }
            __builtin_amdgcn_fence(__ATOMIC_ACQUIRE, "agent");
        }
        asm volatile("s_waitcnt vmcnt(0) lgkmcnt(0)" ::: "memory"); __builtin_amdgcn_s_barrier(); asm volatile("" ::: "memory");
        if (wid < 4) { const unsigned* sp = slot + ((size_t)(u.pm * 256 + tid)) * 4; float t = 0.f;
#pragma unroll
            for (int k = 0; k < 4; ++k) t += __uint_as_float(__hip_atomic_load(sp + k, __ATOMIC_RELAXED, __HIP_MEMORY_SCOPE_AGENT));
            S[tid] = t; }
        asm volatile("s_waitcnt lgkmcnt(0)" ::: "memory"); __builtin_amdgcn_s_barrier(); asm volatile("" ::: "memory");
    }
};
struct EpiFused {
    static constexpr bool FUSED = true;
    const float* xin; float* xout; bf16_t* XN; const float* gpost; const float* modg; int gate_chunk; const float* gpre; const float* modn; int sc_chunk, sh_chunk; RowStat stA, stC; int do_norm;
    __device__ __forceinline__ void fused(f32x4 (&acc)[2][2][4][2], const pg8::Unit& u, int wr, int wc, int fr, int fq, LAS unsigned char* lds, int wid, int lane, int tid) const {
        int frv = fr, fqv = fq; asm volatile("" : "+v"(frv), "+v"(fqv));
        const int b = (u.pm * 256) / SEQ, rloc0 = wr * 64 + frv, colb = u.pn * 256 + wc * 32 + 8 * fqv;
        const LAS float* S = (const LAS float*)(lds + TAB_OFF + 4096);
        float part[8];
#pragma unroll
        for (int i = 0; i < 8; ++i) part[i] = sumsq8(acc[i >> 2][0][i & 3][0], acc[i >> 2][0][i & 3][1]) + sumsq8(acc[i >> 2][1][i & 3][0], acc[i >> 2][1][i & 3][1]);
        stA.run(part, u, wr, wc, fr, fq, lds, wid, lane, tid);
        { f32x4 gg[2][2];
#pragma unroll
          for (int bj = 0; bj < 2; ++bj)
#pragma unroll
            for (int n = 0; n < 2; ++n) gg[bj][n] = *(const f32x4*)(modg + (size_t)b * 6144 + gate_chunk * 1024 + colb + 128 * bj + 4 * n) * *(const f32x4*)(gpost + colb + 128 * bj + 4 * n);
#pragma unroll
          for (int ai = 0; ai < 2; ++ai)
#pragma unroll
            for (int m = 0; m < 4; ++m) { const int rl = ai * 128 + rloc0 + m * 16; const float rs = rsqrtf(S[rl] * (1.f / DM) + RMS_EPS); const size_t off = (size_t)(u.pm * 256 + rl) * DM + colb;
#pragma unroll
                for (int bj = 0; bj < 2; ++bj)
#pragma unroll
                    for (int n = 0; n < 2; ++n) { const f32x4 xo = *(const f32x4*)(xin + off + 128 * bj + 4 * n); const f32x4 xn = xo + acc[ai][bj][m][n] * (gg[bj][n] * rs); acc[ai][bj][m][n] = xn; *(f32x4*)(xout + off + 128 * bj + 4 * n) = xn; }
                asm volatile("" ::: "memory"); } }
        if (!do_norm) return;
#pragma unroll
        for (int i = 0; i < 8; ++i) part[i] = sumsq8(acc[i >> 2][0][i & 3][0], acc[i >> 2][0][i & 3][1]) + sumsq8(acc[i >> 2][1][i & 3][0], acc[i >> 2][1][i & 3][1]);
        stC.run(part, u, wr, wc, fr, fq, lds, wid, lane, tid);
        { f32x4 gs[2][2], sh[2][2];
#pragma unroll
          for (int bj = 0; bj < 2; ++bj)
#pragma unroll
            for (int n = 0; n < 2; ++n) { const int c = colb + 128 * bj + 4 * n; gs[bj][n] = *(const f32x4*)(gpre + c) * (*(const f32x4*)(modn + (size_t)b * 6144 + sc_chunk * 1024 + c) + 1.f); sh[bj][n] = *(const f32x4*)(modn + (size_t)b * 6144 + sh_chunk * 1024 + c); }
#pragma unroll
          for (int ai = 0; ai < 2; ++ai)
#pragma unroll
            for (int m = 0; m < 4; ++m) { const int rl = ai * 128 + rloc0 + m * 16; const float rs = rsqrtf(S[rl] * (1.f / DM) + RMS_EPS); const size_t off = (size_t)(u.pm * 256 + rl) * DM + colb;
#pragma unroll
                for (int bj = 0; bj < 2; ++bj) *(u32x4*)(XN + off + 128 * bj) = pack8(acc[ai][bj][m][0] * (gs[bj][0] * rs) + sh[bj][0], acc[ai][bj][m][1] * (gs[bj][1] * rs) + sh[bj][1]);
            } }
    }
};

namespace att {
constexpr int STG = 21504, OFF_V = 12288, OFF_KPOS = 20480, NBUF = 6, WSF_OFF = NBUF * STG, LDS_BYTES = WSF_OFF + 8 * 256;
constexpr float THR = 8.f;
constexpr float SKIP_T = 24.f;
constexpr int MASK_OFF = 131072 + 512;
struct Unit {
    const bf16_t* Q; int qp; const bf16_t* K1; int k1p; const bf16_t* K2; int k2p; const bf16_t* V; int vp;
    const float* posf; int r, d, n, i0, kbase, ntiles, radius;
    float slope2, m_init, l_init;
    bf16_t* O; int op; float* lse; float lam, cscale; const float* gdiff;
    int hsplit; float slope2b, m_initb;
    const float* pmm; float kn0, kn1;
};
__device__ __forceinline__ float mx3(float a, float b, float c) { return fmaxf(fmaxf(a, b), c); }
__device__ __forceinline__ s16x4 vtr(const LAS unsigned char* p) { return __builtin_bit_cast(s16x4, __builtin_amdgcn_ds_read_tr16_b64_v4i16((LAS s16x4*)p)); }
__device__ __forceinline__ float xhalf(float v, bool sum) { auto rr = __builtin_amdgcn_permlane32_swap(__float_as_uint(v), __float_as_uint(v), false, false);
    const float a = __uint_as_float(rr[0]), b = __uint_as_float(rr[1]); return sum ? a + b : fmaxf(a, b); }
__device__ __forceinline__ void glds16(const void* gsrc, unsigned lds_dst) { unsigned keep;
    asm volatile("s_mov_b32 %0, m0\n\ts_mov_b32 m0, %2\n\ts_nop 0\n\tglobal_load_lds_dwordx4 %1, off\n\ts_mov_b32 m0, %0" : "=&s"(keep) : "v"(gsrc), "s"(lds_dst) : "memory"); }
__device__ __forceinline__ void glds4(const void* gsrc, unsigned lds_dst) { unsigned keep;
    asm volatile("s_mov_b32 %0, m0\n\ts_mov_b32 m0, %2\n\ts_nop 0\n\tglobal_load_lds_dword %1, off\n\ts_mov_b32 m0, %0" : "=&s"(keep) : "v"(gsrc), "s"(lds_dst) : "memory"); }
template <int MODE>
__device__ __forceinline__ void attn_unit(const Unit& u, LAS unsigned char* lds, const int tid) {
    constexpr int DQK = (MODE == 2) ? 96 : 64, NMAP = (MODE == 1) ? 2 : 1, ND0 = DQK / 16;
    const int lane = tid & 63, r32 = lane & 31, hi = lane >> 5, wid = __builtin_amdgcn_readfirstlane(tid >> 6);
    LAS float* wsf = (LAS float*)(lds + WSF_OFF) + wid * 64;
    const int wrow = (MODE == 0 && u.hsplit) ? (wid & 3) : wid, hh = (MODE == 0 && u.hsplit) ? (wid >> 2) : 0;
    const float slope2 = (MODE == 0 && hh) ? u.slope2b : u.slope2;
    const int qi = u.i0 + 32 * wrow + r32, qtok = u.r + u.d * qi;
    bf16x8 q[ND0];
#pragma unroll
    for (int d0 = 0; d0 < ND0; ++d0) q[d0] = *(const bf16x8*)(u.Q + (size_t)qtok * u.qp + 64 * hh + 16 * d0 + 8 * hi);
    float pq = (MODE != 2) ? u.posf[qtok] : 0.f;
#pragma unroll
    for (int d0 = 0; d0 < ND0; ++d0) asm volatile("" : "+v"(q[d0]));
    asm volatile("" : "+v"(pq));
    const unsigned lds0 = (unsigned)(uintptr_t)lds;
#define ATT_LOAD(j, buf) do { const unsigned st_ = (unsigned)__builtin_amdgcn_readfirstlane((int)(lds0 + (unsigned)(buf) * STG)); \
        { int idx = u.kbase + 64 * (j) + lane; idx = idx < 0 ? 0 : (idx > u.n - 1 ? u.n - 1 : idx); const size_t tok = (size_t)(u.r + u.d * idx); \
            glds16(u.K1 + tok * u.k1p + 8 * wid, st_ + wid * 1024); \
            if (MODE == 2 && wid < 4) glds16(u.K2 + tok * u.k2p + 8 * wid, st_ + (8 + wid) * 1024); \
            if (MODE != 2 && wid == 7) glds4(u.posf + tok, st_ + OFF_KPOS); } \
        { int idx = u.kbase + 64 * (j) + 16 * (wid & 3) + (lane >> 2); idx = idx < 0 ? 0 : (idx > u.n - 1 ? u.n - 1 : idx); const size_t tok = (size_t)(u.r + u.d * idx); \
            glds16(u.V + tok * u.vp + 32 * (wid >> 2) + 8 * (lane & 3), st_ + OFF_V + wid * 1024); } } while (0)
#define ATT_STORE(buf) do { } while (0)
#define ATT_SYNC() asm volatile("s_waitcnt vmcnt(0) lgkmcnt(0)\n\ts_barrier" ::: "memory")
    float m_run[NMAP], l_run[NMAP]; f32x16 o[NMAP][2];
#pragma unroll
    for (int mp = 0; mp < NMAP; ++mp) { m_run[mp] = MODE == 2 ? 0.f : ((MODE == 0 && hh) ? u.m_initb : u.m_init); l_run[mp] = hi == 0 ? u.l_init : 0.f; o[mp][0] = f32x16{}; o[mp][1] = f32x16{}; }
    int j_lo = 0, j_hi = u.ntiles - 1;
    if (MODE == 0) { j_lo = wrow >> 1; j_hi = (32 * wrow + 31 + 2 * u.radius) >> 6; }
    constexpr int NPASS = (MODE == 1) ? 2 : 1;
    constexpr bool STAG = (MODE != 1);
    const bool late = STAG && (wid >= 4);
    bf16x8 pa[4]; bool pend = false; int bprev = 0; bool first = true;
    f32x16 negm = f32x16{};
    if (MODE == 2) { float z_ = 0.f; asm volatile("" : "+v"(z_));
#pragma unroll
        for (int r = 0; r < 16; ++r) negm[r] = z_; }
#define ATT_PV(stp, oacc) do { unsigned vbo = (unsigned)(uintptr_t)((stp) + OFF_V + ((lane >> 4) & 1) * 32 + (lane & 3) * 8 + (4 * hi + ((lane & 15) >> 2)) * 64); asm volatile("" : "+v"(vbo)); \
        const LAS unsigned char* vbm = (const LAS unsigned char*)(uintptr_t)vbo; \
        _Pragma("unroll") for (int dblk = 0; dblk < 2; ++dblk) _Pragma("unroll") for (int s4 = 0; s4 < 4; ++s4) { \
            const s16x4 lo = vtr(vbm + dblk * 4096 + s4 * 1024), hh = vtr(vbm + dblk * 4096 + s4 * 1024 + 512); \
            const bf16x8 bv = {lo[0], lo[1], lo[2], lo[3], hh[0], hh[1], hh[2], hh[3]}; \
            (oacc)[dblk] = __builtin_amdgcn_mfma_f32_32x32x16_bf16(pa[s4], bv, (oacc)[dblk], 0, 0, 0); } } while (0)
#pragma unroll 1
    for (int pass = 0; pass < NPASS; ++pass) {
        unsigned long long bm, wm;
        if (MODE == 1) {
            const unsigned long long diag = 0xFull << (u.i0 >> 6);
            if (pass == 0) { bm = diag; wm = diag; }
            else {
                float qn0, qn1, pqmin = pq, pqmax = pq;
                { float s0 = 0.f, s1 = 0.f;
#pragma unroll
                  for (int e = 0; e < 8; ++e) { const float a0 = bf2f((bf16_t)q[0][e]), a1 = bf2f((bf16_t)q[1][e]), b0 = bf2f((bf16_t)q[ND0 - 2][e]), b1 = bf2f((bf16_t)q[ND0 - 1][e]); s0 += a0 * a0 + a1 * a1; s1 += b0 * b0 + b1 * b1; }
                  s0 = xhalf(s0, true); s1 = xhalf(s1, true);
#pragma unroll
                  for (int o_ = 1; o_ < 32; o_ <<= 1) { s0 = fmaxf(s0, __shfl_xor(s0, o_)); s1 = fmaxf(s1, __shfl_xor(s1, o_)); pqmin = fminf(pqmin, __shfl_xor(pqmin, o_)); pqmax = fmaxf(pqmax, __shfl_xor(pqmax, o_)); }
                  qn0 = sqrtf(s0); qn1 = sqrtf(s1); }
                float ml0 = m_run[0], ml1 = m_run[NMAP - 1];
#pragma unroll
                for (int o_ = 1; o_ < 32; o_ <<= 1) { ml0 = fminf(ml0, __shfl_xor(ml0, o_)); ml1 = fminf(ml1, __shfl_xor(ml1, o_)); }
                const float pmn = u.pmm[2 * lane], pmx = u.pmm[2 * lane + 1];
                const float pen = u.slope2 * fmaxf(0.f, fmaxf(pmn - pqmax, pqmin - pmx));
                const bool need = (qn0 * u.kn0 - pen >= ml0 - SKIP_T) || (qn1 * u.kn1 - pen >= ml1 - SKIP_T);
                wm = __ballot(need) & ~diag;
                LAS unsigned long long* mk = (LAS unsigned long long*)(lds + MASK_OFF);
                if (lane == 0) mk[wid] = wm;
                __syncthreads();
                unsigned long long un = 0ull;
#pragma unroll
                for (int w = 0; w < 8; ++w) un |= mk[w];
                bm = ((unsigned long long)(unsigned)__builtin_amdgcn_readfirstlane((int)(un >> 32)) << 32) | (unsigned)__builtin_amdgcn_readfirstlane((int)un);
            }
        } else {
            bm = u.ntiles >= 64 ? ~0ull : ((1ull << u.ntiles) - 1ull);
            wm = bm; if (MODE == 0) wm = (j_hi >= 63 ? ~0ull : ((1ull << (j_hi + 1)) - 1ull)) & ~((1ull << j_lo) - 1ull);
        }
        if (bm == 0ull) continue;
        const bool preload = (MODE == 0) && (u.ntiles <= NBUF);
        if (preload) {
#pragma unroll 1
            for (int t = 0; t < u.ntiles; ++t) { ATT_LOAD(t, t); asm volatile("" ::: "memory"); }
        }
        int j = __builtin_ctzll(bm); bm &= bm - 1ull; int buf = 0;
        if (!preload) { ATT_LOAD(j, 0); ATT_STORE(0); }
        ATT_SYNC();
        for (;;) {
        const bool more = bm != 0ull; int jn = 0; const int bnext = buf == NBUF - 1 ? 0 : buf + 1;
        if (more) { jn = __builtin_ctzll(bm); bm &= bm - 1ull; if (!preload) ATT_LOAD(jn, bnext); }
        if (STAG && late && pend) { ATT_PV(lds + bprev * STG, o[0]); pend = false; }
        if ((wm >> j) & 1ull) {
            const LAS unsigned char* st = lds + buf * STG;
            const LAS unsigned char* kb = st + hi * 1024 + r32 * 16;
#pragma unroll
            for (int mp = 0; mp < NMAP; ++mp) {
                f32x16 p0, p1;
                constexpr int DPM = ND0 / NMAP;
#pragma unroll
                for (int dd = 0; dd < DPM; ++dd) { const int d0 = mp * DPM + dd;
                    const bf16x8 a0 = *(const LAS bf16x8*)(kb + d0 * 2048), a1 = *(const LAS bf16x8*)(kb + d0 * 2048 + 512);
                    if (dd == 0) { const f32x16 c0 = (MODE == 2) ? negm : f32x16{}; p0 = __builtin_amdgcn_mfma_f32_32x32x16_bf16(a0, q[d0], c0, 0, 0, 0); p1 = __builtin_amdgcn_mfma_f32_32x32x16_bf16(a1, q[d0], c0, 0, 0, 0); }
                    else { p0 = __builtin_amdgcn_mfma_f32_32x32x16_bf16(a0, q[d0], p0, 0, 0, 0); p1 = __builtin_amdgcn_mfma_f32_32x32x16_bf16(a1, q[d0], p1, 0, 0, 0); } }
                if (MODE != 2) {
                    unsigned sto = (unsigned)(uintptr_t)st; asm volatile("" : "+v"(sto)); const LAS unsigned char* stm = (const LAS unsigned char*)(uintptr_t)sto;
#pragma unroll
                    for (int g = 0; g < 4; ++g) {
                        const f32x4 ka = *(const LAS f32x4*)(stm + OFF_KPOS + 4 * (8 * g + 4 * hi)), kb4 = *(const LAS f32x4*)(stm + OFF_KPOS + 4 * (32 + 8 * g + 4 * hi));
#pragma unroll
                        for (int e = 0; e < 4; ++e) { const int r = 4 * g + e;
                            float s0 = p0[r] - slope2 * fabsf(pq - ka[e]), s1 = p1[r] - slope2 * fabsf(pq - kb4[e]);
                            if (MODE == 0) { const int k0 = u.kbase + 64 * j + 8 * g + 4 * hi + e, k1 = k0 + 32;
                                if ((unsigned)(k0 - qi + u.radius) > (unsigned)(2 * u.radius) || (unsigned)k0 >= (unsigned)u.n) s0 = -1e30f;
                                if ((unsigned)(k1 - qi + u.radius) > (unsigned)(2 * u.radius) || (unsigned)k1 >= (unsigned)u.n) s1 = -1e30f; }
                            p0[r] = s0; p1[r] = s1; }
                    }
                }
                float ra = mx3(p0[0], p0[1], p1[0]), rb = mx3(p0[2], p0[3], p1[1]); ra = mx3(ra, p1[2], p1[3]);
#pragma unroll
                for (int r = 4; r < 16; r += 4) { ra = mx3(ra, p0[r], p0[r + 1]); rb = mx3(rb, p0[r + 2], p0[r + 3]); ra = mx3(ra, p1[r], p1[r + 1]); rb = mx3(rb, p1[r + 2], p1[r + 3]); }
                const float rm = xhalf(fmaxf(ra, rb), false);
                float mr;
                if (MODE == 2) {
                    if (first || __any(rm > THR)) {
                        const float dl = first ? rm : fmaxf(rm, 0.f); m_run[mp] += dl;
#pragma unroll
                        for (int r = 0; r < 16; ++r) { p0[r] -= dl; p1[r] -= dl; negm[r] = -m_run[mp]; }
                        if (!first) { const float f = __builtin_amdgcn_exp2f(-dl); l_run[mp] *= f; if (hi == 0) wsf[r32] = f;
                            __builtin_amdgcn_wave_barrier();
#pragma unroll
                            for (int g = 0; g < 4; ++g) { const f32x4 f4 = *(const LAS f32x4*)(wsf + 8 * g + 4 * hi);
#pragma unroll
                                for (int e = 0; e < 4; ++e) { o[mp][0][4 * g + e] *= f4[e]; o[mp][1][4 * g + e] *= f4[e]; } }
                            __builtin_amdgcn_wave_barrier(); }
                        first = false;
                    }
                    mr = 0.f;
                } else {
                    if (__any(rm > m_run[mp] + THR)) {
                        const float mn = fmaxf(m_run[mp], rm); const float f = __builtin_amdgcn_exp2f(m_run[mp] - mn); l_run[mp] *= f; m_run[mp] = mn; if (hi == 0) wsf[r32] = f;
                        __builtin_amdgcn_wave_barrier();
#pragma unroll
                        for (int g = 0; g < 4; ++g) { const f32x4 f4 = *(const LAS f32x4*)(wsf + 8 * g + 4 * hi);
#pragma unroll
                            for (int e = 0; e < 4; ++e) { o[mp][0][4 * g + e] *= f4[e]; o[mp][1][4 * g + e] *= f4[e]; } }
                        __builtin_amdgcn_wave_barrier();
                    }
                    mr = m_run[mp];
                }
                float s = 0.f;
#pragma unroll
                for (int r = 0; r < 16; ++r) { p0[r] = __builtin_amdgcn_exp2f(MODE == 2 ? p0[r] : p0[r] - mr); p1[r] = __builtin_amdgcn_exp2f(MODE == 2 ? p1[r] : p1[r] - mr); s += p0[r] + p1[r]; }
                l_run[mp] += s;
#pragma unroll
                for (int s2 = 0; s2 < 2; ++s2) {
                    u32x4 w; w.x = cvtpk(p0[8 * s2], p0[8 * s2 + 1]); w.y = cvtpk(p0[8 * s2 + 2], p0[8 * s2 + 3]); w.z = cvtpk(p0[8 * s2 + 4], p0[8 * s2 + 5]); w.w = cvtpk(p0[8 * s2 + 6], p0[8 * s2 + 7]); pa[s2] = __builtin_bit_cast(bf16x8, w);
                    u32x4 x; x.x = cvtpk(p1[8 * s2], p1[8 * s2 + 1]); x.y = cvtpk(p1[8 * s2 + 2], p1[8 * s2 + 3]); x.z = cvtpk(p1[8 * s2 + 4], p1[8 * s2 + 5]); x.w = cvtpk(p1[8 * s2 + 6], p1[8 * s2 + 7]); pa[2 + s2] = __builtin_bit_cast(bf16x8, x); }
                if (STAG && late) { pend = true; bprev = buf; }
                else { ATT_PV(st, o[mp]); }
                if (NMAP > 1) __builtin_amdgcn_sched_barrier(0);
            }
        }
        if (!more) break;
        if (!preload) { ATT_STORE(bnext); ATT_SYNC(); }
        j = jn; buf = bnext;
        }
        if (STAG && late && pend) { ATT_PV(lds + bprev * STG, o[0]); pend = false; }
        ATT_SYNC();
    }
#undef ATT_PV
#undef ATT_LOAD
#undef ATT_STORE
#undef ATT_SYNC
    int r32v = r32, hiv = hi, widv = wrow, hhv = hh; asm volatile("" : "+v"(r32v), "+v"(hiv), "+s"(widv), "+s"(hhv));
    float lt[NMAP];
#pragma unroll
    for (int mp = 0; mp < NMAP; ++mp) lt[mp] = xhalf(l_run[mp], true);
    if (MODE == 0 && u.lse && hiv == 0) u.lse[(size_t)(u.r + u.d * (u.i0 + 32 * widv + r32v)) * 4] = m_run[0] + __builtin_amdgcn_logf(lt[0]);
    if (hiv == 0) { wsf[r32v] = 1.f / lt[0]; if (MODE == 1) wsf[32 + r32v] = u.lam / lt[NMAP - 1]; }
    __builtin_amdgcn_wave_barrier();
    float val[2][16];
#pragma unroll
    for (int g = 0; g < 4; ++g) { const f32x4 f4 = *(const LAS f32x4*)(wsf + 8 * g + 4 * hiv); f32x4 h4 = {0.f, 0.f, 0.f, 0.f}; if (MODE == 1) h4 = *(const LAS f32x4*)(wsf + 32 + 8 * g + 4 * hiv);
#pragma unroll
        for (int e = 0; e < 4; ++e) { const int r = 4 * g + e;
#pragma unroll
            for (int dblk = 0; dblk < 2; ++dblk) { float v = o[0][dblk][r] * f4[e]; if (MODE == 1) v -= o[NMAP - 1][dblk][r] * h4[e]; val[dblk][r] = v; } } }
    __builtin_amdgcn_wave_barrier();
    if (MODE == 1) {
        const float g0 = u.gdiff[r32v], g1 = u.gdiff[32 + r32v];
#pragma unroll
        for (int r = 0; r < 16; ++r) { float ss = val[0][r] * val[0][r] + val[1][r] * val[1][r];
            ss += __shfl_xor(ss, 1); ss += __shfl_xor(ss, 2); ss += __shfl_xor(ss, 4); ss += __shfl_xor(ss, 8); ss += __shfl_xor(ss, 16);
            const float rs = rsqrtf(ss * (1.f / 64.f) + RMS_EPS) * u.cscale; val[0][r] *= rs * g0; val[1][r] *= rs * g1; }
    }
#pragma unroll
    for (int r = 0; r < 16; ++r) { const int qr = u.i0 + 32 * widv + (r & 3) + 8 * (r >> 2) + 4 * hiv; const size_t tok = (size_t)(u.r + u.d * qr);
        bf16_t* op_ = u.O + tok * u.op + 64 * hhv + r32v; op_[0] = f2bf(val[0][r]); op_[32] = f2bf(val[1][r]); }
}
__device__ __forceinline__ float x16(float v, bool sum) { auto rr = __builtin_amdgcn_permlane16_swap(__float_as_uint(v), __float_as_uint(v), false, false);
    const float a = __uint_as_float(rr[0]), b = __uint_as_float(rr[1]); return sum ? a + b : fmaxf(a, b); }
__device__ __forceinline__ void attn_unit_d16(const Unit& u, LAS unsigned char* lds, const int tid) {
    const int lane = tid & 63, r16 = lane & 15, q4 = lane >> 4, wid = __builtin_amdgcn_readfirstlane(tid >> 6);
    LAS float* wsf = (LAS float*)(lds + WSF_OFF) + wid * 64;
    const unsigned lds0 = (unsigned)(uintptr_t)lds;
#define ATT6_LOAD(j, buf) do { const unsigned st_ = (unsigned)__builtin_amdgcn_readfirstlane((int)(lds0 + (unsigned)(buf) * STG)); \
        { const size_t tok = (size_t)(64 * (j) + lane); \
            glds16(u.K1 + tok * u.k1p + 8 * wid, st_ + wid * 1024); \
            if (wid < 4) glds16(u.K2 + tok * u.k2p + 8 * wid, st_ + (8 + wid) * 1024); } \
        { const size_t tok = (size_t)(64 * (j) + 16 * (wid & 3) + (lane >> 2)); \
            glds16(u.V + tok * u.vp + 32 * (wid >> 2) + 8 * (lane & 3), st_ + OFF_V + wid * 1024); } } while (0)
#define ATT6_SYNC() asm volatile("s_waitcnt vmcnt(0) lgkmcnt(0)\n\ts_barrier" ::: "memory")
    ATT6_LOAD(0, 0);
    bf16x8 qf[2][3];
#pragma unroll
    for (int rb = 0; rb < 2; ++rb)
#pragma unroll
        for (int s_ = 0; s_ < 3; ++s_) qf[rb][s_] = *(const bf16x8*)(u.Q + (size_t)(u.i0 + 32 * wid + 16 * rb + r16) * u.qp + 32 * s_ + 8 * q4);
#pragma unroll
    for (int rb = 0; rb < 2; ++rb)
#pragma unroll
        for (int s_ = 0; s_ < 3; ++s_) asm volatile("" : "+v"(qf[rb][s_]));
    float m_run[2] = {0.f, 0.f}, l_run[2] = {0.f, 0.f}; f32x4 negm[2], o[2][4];
    { float z_ = 0.f; asm volatile("" : "+v"(z_));
#pragma unroll
      for (int rb = 0; rb < 2; ++rb) { negm[rb] = (f32x4){z_, z_, z_, z_};
#pragma unroll
        for (int dc = 0; dc < 4; ++dc) o[rb][dc] = (f32x4){z_, z_, z_, z_}; } }
    const bool late = wid >= 4; bool pend = false; int bprev = 0;
    bf16x8 pa[2][2];
#define ATT6_PV(stp) do { unsigned vbo = (unsigned)(uintptr_t)((stp) + OFF_V + (4 * q4 + (r16 >> 2)) * 64 + (r16 & 3) * 8); asm volatile("" : "+v"(vbo)); \
        const LAS unsigned char* vbm = (const LAS unsigned char*)(uintptr_t)vbo; \
        _Pragma("unroll") for (int dc = 0; dc < 4; ++dc) _Pragma("unroll") for (int ks = 0; ks < 2; ++ks) { \
            const s16x4 lo = vtr(vbm + (dc >> 1) * 4096 + (dc & 1) * 32 + ks * 2048), hh = vtr(vbm + (dc >> 1) * 4096 + (dc & 1) * 32 + ks * 2048 + 1024); \
            const bf16x8 bv = {lo[0], lo[1], lo[2], lo[3], hh[0], hh[1], hh[2], hh[3]}; \
            o[0][dc] = __builtin_amdgcn_mfma_f32_16x16x32_bf16(pa[0][ks], bv, o[0][dc], 0, 0, 0); o[1][dc] = __builtin_amdgcn_mfma_f32_16x16x32_bf16(pa[1][ks], bv, o[1][dc], 0, 0, 0); } } while (0)
    const int nt = u.ntiles;
    ATT6_SYNC();
    int buf = 0;
#pragma unroll 1
    for (int j = 0; j < nt; ++j) {
        const int bnext = buf == NBUF - 1 ? 0 : buf + 1;
        if (j + 1 < nt) ATT6_LOAD(j + 1, bnext);
        if (late && pend) { ATT6_PV(lds + bprev * STG); pend = false; }
        const LAS unsigned char* st = lds + buf * STG;
        const LAS unsigned char* kb_ = st + q4 * 1024 + r16 * 16;
        f32x4 sc[2][4];
#pragma unroll
        for (int s_ = 0; s_ < 3; ++s_)
#pragma unroll
            for (int kb = 0; kb < 4; ++kb) { const bf16x8 kf = *(const LAS bf16x8*)(kb_ + s_ * 4096 + kb * 256);
#pragma unroll
                for (int rb = 0; rb < 2; ++rb) sc[rb][kb] = __builtin_amdgcn_mfma_f32_16x16x32_bf16(kf, qf[rb][s_], s_ == 0 ? negm[rb] : sc[rb][kb], 0, 0, 0); }
#pragma unroll
        for (int rb = 0; rb < 2; ++rb) {
            float ra = mx3(sc[rb][0][0], sc[rb][0][1], sc[rb][0][2]), rb_ = mx3(sc[rb][0][3], sc[rb][1][0], sc[rb][1][1]);
            ra = mx3(ra, sc[rb][1][2], sc[rb][1][3]); rb_ = mx3(rb_, sc[rb][2][0], sc[rb][2][1]); ra = mx3(ra, sc[rb][2][2], sc[rb][2][3]); rb_ = mx3(rb_, sc[rb][3][0], sc[rb][3][1]); ra = mx3(ra, sc[rb][3][2], sc[rb][3][3]);
            const float rm = xhalf(x16(fmaxf(ra, rb_), false), false);
            if (j == 0 || __any(rm > THR)) {
                const float dl = j == 0 ? rm : fmaxf(rm, 0.f); m_run[rb] += dl;
#pragma unroll
                for (int kb = 0; kb < 4; ++kb) sc[rb][kb] = sc[rb][kb] - dl;
                negm[rb] = (f32x4){-m_run[rb], -m_run[rb], -m_run[rb], -m_run[rb]};
                if (j != 0) { const float f = __builtin_amdgcn_exp2f(-dl); l_run[rb] *= f; if (q4 == 0) wsf[16 * rb + r16] = f;
                    __builtin_amdgcn_wave_barrier();
                    const f32x4 f4 = *(const LAS f32x4*)(wsf + 16 * rb + 4 * q4);
#pragma unroll
                    for (int dc = 0; dc < 4; ++dc) o[rb][dc] = o[rb][dc] * f4;
                    __builtin_amdgcn_wave_barrier(); }
            }
            float sm = 0.f;
#pragma unroll
            for (int kb = 0; kb < 4; ++kb)
#pragma unroll
                for (int e = 0; e < 4; ++e) { sc[rb][kb][e] = __builtin_amdgcn_exp2f(sc[rb][kb][e]); sm += sc[rb][kb][e]; }
            l_run[rb] += sm;
#pragma unroll
            for (int ks = 0; ks < 2; ++ks) { u32x4 w; w.x = cvtpk(sc[rb][2 * ks][0], sc[rb][2 * ks][1]); w.y = cvtpk(sc[rb][2 * ks][2], sc[rb][2 * ks][3]);
                w.z = cvtpk(sc[rb][2 * ks + 1][0], sc[rb][2 * ks + 1][1]); w.w = cvtpk(sc[rb][2 * ks + 1][2], sc[rb][2 * ks + 1][3]); pa[rb][ks] = __builtin_bit_cast(bf16x8, w); }
        }
        if (late) { pend = true; bprev = buf; } else { ATT6_PV(st); }
        if (j + 1 == nt) break;
        ATT6_SYNC();
        buf = bnext;
    }
    if (late && pend) { ATT6_PV(lds + bprev * STG); pend = false; }
    ATT6_SYNC();
#undef ATT6_PV
#undef ATT6_LOAD
#undef ATT6_SYNC
    int r16v = r16, q4v = q4, widv = wid; asm volatile("" : "+v"(r16v), "+v"(q4v), "+s"(widv));
#pragma unroll
    for (int rb = 0; rb < 2; ++rb) {
        const float lt = xhalf(x16(l_run[rb], true), true);
        if (q4v == 0) wsf[16 * rb + r16v] = 1.f / lt;
        __builtin_amdgcn_wave_barrier();
        const f32x4 f4 = *(const LAS f32x4*)(wsf + 16 * rb + 4 * q4v);
        __builtin_amdgcn_wave_barrier();
#pragma unroll
        for (int e = 0; e < 4; ++e) { const int qr = u.i0 + 32 * widv + 16 * rb + 4 * q4v + e; bf16_t* op_ = u.O + (size_t)qr * u.op + r16v;
#pragma unroll
            for (int dc = 0; dc < 4; ++dc) op_[16 * dc] = f2bf(o[rb][dc][e] * f4[e]); }
    }
}
}
#include <hip/hip_cooperative_groups.h>
namespace cg = cooperative_groups;
constexpr int NTHREADS = 512, NWAVES = 8;
constexpr int LDS_TOTAL = 131072 + 1024 + 4096 + 1024 + 64;
constexpr int WCONV_SPLIT = 0;
constexpr int KRSPLIT = 1;
constexpr int PJ_DIV = 4;
constexpr int XQUEUE = 1;
constexpr int FUSE_E = 1;
constexpr int NPH = 2 + 8 * DEPTH;
#ifndef MK_EN
#define MK_EN 0xFFFF
#endif
#define EN(b) ((MK_EN >> (b)) & 1)
struct MKArgs { const float* in[23]; float* out; unsigned char* ws; int ph_lo, ph_hi, xmask, ymask; };

#define GAS __attribute__((address_space(1)))
constexpr int CW_KMAX = 8192;
constexpr int CW_BAR = 4096;
constexpr size_t CTL_ZERO_BYTES = 65536 + 8 * 32768;
constexpr int CW_QUEUE = 12288;
constexpr int CW_CNT = 16384;
constexpr int MISC_OFF = 131072;
#define XB_TMO      128
#define XB_XCNT(j)  (256  + 64 * (j))
#define XB_XSUB(j)  (1280 + 64 * (j))
#define XB_XGEN(j)  (2304 + 64 * (j))
#define XB_TOP      3328
#define XB_TOPGEN   3392
#define XCD_BAR_WORDS 3456
#define XB_SPIN_CAP (1u << 18)

__device__ __forceinline__ unsigned xb_ld(unsigned* p)              { return __hip_atomic_load(p, __ATOMIC_RELAXED, __HIP_MEMORY_SCOPE_AGENT); }
__device__ __forceinline__ unsigned xb_add(unsigned* p, unsigned v) { return __hip_atomic_fetch_add(p, v, __ATOMIC_RELAXED, __HIP_MEMORY_SCOPE_AGENT); }
__device__ __forceinline__ unsigned xb_xcc_id() { return (unsigned)__builtin_amdgcn_s_getreg((3 << 11) | 20) & 0xFu; }
#define XB_SPIN(cond, bar) do { unsigned _sp = 0; while (cond) { __builtin_amdgcn_s_sleep(1); \
    if ((++_sp & 255u) == 0u) { if (xb_ld(&(bar)[XB_TMO])) break; if (_sp > XB_SPIN_CAP) { atomicAdd(&(bar)[XB_TMO], 1u); break; } } } } while (0)

struct XcdBarrier {
    unsigned* bar; unsigned x;
    volatile LAS unsigned* st;
};

__device__ __forceinline__ XcdBarrier xcd_barrier_post(unsigned* bar, volatile LAS unsigned* st) {
    XcdBarrier b; b.bar = bar; b.x = xb_xcc_id(); b.st = st;
    if (threadIdx.x == 0) (void)xb_add(&bar[XB_XCNT(b.x)], 1u);
    return b;
}
__device__ __forceinline__ void xcd_barrier_complete(unsigned* bar, unsigned x, unsigned& nloc, unsigned& nx) {
    const unsigned G = gridDim.x * gridDim.y * gridDim.z;
    unsigned sum, cnt, mine, sp = 0u;
    for (;;) {
        sum = 0u; cnt = 0u; mine = 0u;
#pragma unroll
        for (unsigned j = 0; j < 16; ++j) { const unsigned c = xb_ld(&bar[XB_XCNT(j)]); sum += c; cnt += (c > 0u) ? 1u : 0u; mine = (j == x) ? c : mine; }
        if (sum == G) break;
        __builtin_amdgcn_s_sleep(1);
        if ((++sp & 255u) == 0u) { if (xb_ld(&bar[XB_TMO])) break; if (sp > XB_SPIN_CAP) { atomicAdd(&bar[XB_TMO], 1u); break; } }
    }
    nloc = mine > 0u ? mine : 1u; nx = cnt > 0u ? cnt : 1u;
}

__device__ __forceinline__ void xcd_barrier(const XcdBarrier& b, const int tid_) {
    asm volatile("s_waitcnt vmcnt(0)" ::: "memory");
    __syncthreads();
    if (tid_ == 0) {
        unsigned* bar = b.bar;
        __builtin_amdgcn_s_waitcnt(0);
        unsigned nloc = b.st[0], nx = b.st[1];
        if (nloc == 0u) { xcd_barrier_complete(bar, b.x, nloc, nx); b.st[0] = nloc; b.st[1] = nx; }
        const unsigned old = xb_add(&bar[XB_XSUB(b.x)], 1u);
        const unsigned gen = old / nloc;
        if (old + 1u == (gen + 1u) * nloc) {
            __builtin_amdgcn_fence(__ATOMIC_RELEASE, "agent");
            asm volatile("s_waitcnt vmcnt(0)" ::: "memory");
            const unsigned og = xb_add(&bar[XB_TOP], 1u);
            const unsigned tg = og / nx;
            if (og + 1u == (tg + 1u) * nx) xb_add(&bar[XB_TOPGEN], 1u);
            else XB_SPIN(xb_ld(&bar[XB_TOPGEN]) == tg, bar);
            __builtin_amdgcn_fence(__ATOMIC_ACQUIRE, "agent");
            xb_add(&bar[XB_XGEN(b.x)], 1u);
            asm volatile("s_waitcnt vmcnt(0)" ::: "memory");
        } else {
            XB_SPIN(xb_ld(&bar[XB_XGEN(b.x)]) == gen, bar);
            __builtin_amdgcn_fence(__ATOMIC_ACQUIRE, "agent");
            asm volatile("s_waitcnt vmcnt(0)" ::: "memory");
        }
    }
    __syncthreads();
}

__device__ __forceinline__ float wval(const MKArgs& a, int kind, int l, int k, int n) {
    if (kind == 0) { if (n >= IN_W) return 0.f; float v = a.in[7][((size_t)l * 1024 + k) * IN_W + n];
        if (n < 256 || (n >= ZB_Q && n < ZB_Q + 256)) v *= 0.125f * LOG2E; else if (n >= ZC_Q && n < ZC_Q + 256) v *= 0.17677669529663687f * LOG2E; return v; }
    if (kind == 1) { if (n < 512) return k >= 384 ? a.in[15][l * 128 + (k - 384)] * a.in[17][((size_t)l * 128 + (k - 384)) * 512 + n] : 0.f;
        if (n < 896) return k < 384 ? a.in[14][l * 384 + k] * a.in[16][((size_t)l * 384 + k) * 384 + (n - 512)] * (0.10206207261596575f * LOG2E) : 0.f;
        return 0.f; }
    if (kind == 2) return a.in[18][((size_t)l * 1024 + k) * 1024 + n];
    if (kind == 3) { const int pn = n >> 8, wi = n & 255; const int src = wi < 128 ? pn * 128 + wi : DFF + pn * 128 + (wi - 128); return a.in[21][((size_t)l * 1024 + k) * NGU + src]; }
    return a.in[22][((size_t)l * DFF + k) * 1024 + n];
}
__device__ __forceinline__ void transpose_item(const MKArgs& a, int kind, int l, bf16_t* dst, int K, int k0, int n0, LAS float* scr, int lane) {
#pragma unroll
    for (int i = 0; i < 32; ++i) { const int kk = 2 * i + (lane >> 5); scr[kk * 33 + (lane & 31)] = wval(a, kind, l, k0 + kk, n0 + (lane & 31)); }
    asm volatile("s_waitcnt lgkmcnt(0)" ::: "memory");
    const int c = lane & 7;
#pragma unroll
    for (int j = 0; j < 4; ++j) { const int n = (lane >> 3) + 8 * j; const LAS float* s = scr + (8 * c) * 33 + n;
        u32x4 o; o.x = cvtpk(s[0 * 33], s[1 * 33]); o.y = cvtpk(s[2 * 33], s[3 * 33]); o.z = cvtpk(s[4 * 33], s[5 * 33]); o.w = cvtpk(s[6 * 33], s[7 * 33]);
        *(u32x4*)(dst + (size_t)(n0 + n) * K + k0 + 8 * c) = o; }
    asm volatile("s_waitcnt lgkmcnt(0)" ::: "memory");
}
__device__ __forceinline__ void ph_prologue(const MKArgs& a, LAS unsigned char* lds, int bid, int G, const int tid) {
    const int lane = tid & 63, wid = __builtin_amdgcn_readfirstlane(tid >> 6); (void)lane; (void)wid;
    float* MOD = (float*)(a.ws + WS_MOD);
    for (int it = bid; it < DEPTH * 96; it += G) {
        LAS float* sc_ = (LAS float*)lds;
        LAS float* red = (LAS float*)(lds + 32768);
        const int l = it / 96, cb = it % 96, cl = tid & 63, col = cb * 64 + cl, ks = tid >> 6;
        for (int i = tid; i < 8192; i += NTHREADS) { const int b = i >> 10, k = i & 1023; const float cv = a.in[1][i]; sc_[k * 8 + b] = cv / (1.f + expf(-cv)); }
        __syncthreads();
        float acc[8];
#pragma unroll
        for (int b = 0; b < 8; ++b) acc[b] = 0.f;
        const float* w = a.in[3] + (size_t)l * 1024 * 6144;
#pragma unroll 4
        for (int k = ks * 128; k < ks * 128 + 128; ++k) { const float wv = w[(size_t)k * 6144 + col];
            const f32x4 s0 = *(const LAS f32x4*)(sc_ + k * 8), s1 = *(const LAS f32x4*)(sc_ + k * 8 + 4);
#pragma unroll
            for (int b = 0; b < 4; ++b) { acc[b] += s0[b] * wv; acc[4 + b] += s1[b] * wv; } }
#pragma unroll
        for (int b = 0; b < 8; ++b) red[(ks * 8 + b) * 64 + cl] = acc[b];
        __syncthreads();
        { const int b = tid >> 6; float s = a.in[4][l * 6144 + col];
#pragma unroll
          for (int k2 = 0; k2 < 8; ++k2) s += red[(k2 * 8 + b) * 64 + cl];
          MOD[((size_t)l * 8 + b) * 6144 + col] = s; }
        __syncthreads();
    }
    { float* cosT = (float*)(a.ws + WS_COS); float* sinT = (float*)(a.ws + WS_SIN); const int* pos = (const int*)a.in[2];
      for (int idx = bid * NTHREADS + tid; idx < M * 16; idx += G * NTHREADS) { const int m = idx >> 4, i = idx & 15;
          const float inv = exp2f(-(float)i * (13.287712379549449f / 16.0f)); const float pf = (float)pos[m], ang = pf * inv; cosT[idx] = cosf(ang); sinT[idx] = sinf(ang);
          if (i == 0) ((float*)(a.ws + WS_POSF))[m] = pf; } }
    { float* PMM = (float*)(a.ws + WS_PMM); const int* pos = (const int*)a.in[2];
      for (int t = bid * NTHREADS + tid; t < BATCH * 64; t += G * NTHREADS) { int mn = pos[t * 64], mx = mn; for (int i = 1; i < 64; ++i) { const int p = pos[t * 64 + i]; mn = p < mn ? p : mn; mx = p > mx ? p : mx; } PMM[2 * t] = (float)mn; PMM[2 * t + 1] = (float)mx; } }
}
__device__ __forceinline__ void ph_wconv(const MKArgs& a, LAS unsigned char* lds, int bid, int G, const int tid, const int l0, const int l1) {
    const int lane = tid & 63, wid = __builtin_amdgcn_readfirstlane(tid >> 6);
    LAS float* scr = (LAS float*)(lds + wid * 8448);
    constexpr int I0 = 16 * 88, I1 = 8 * 32, I2 = 16 * 32, I3 = 16 * 176, I4 = 44 * 32, IL = I0 + I1 + I2 + I3 + I4;
    for (int it = l0 * IL + bid * NWAVES + wid; it < l1 * IL; it += G * NWAVES) {
        const int l = it / IL; int r = it % IL; bf16_t* W = (bf16_t*)(a.ws + WS_W + (size_t)l * W_LAYER);
        if (r < I0) { transpose_item(a, 0, l, W + W_IN / 2, 1024, 64 * (r / 88), 32 * (r % 88), scr, lane); continue; } r -= I0;
        if (r < I1) { transpose_item(a, 1, l, W + W_UP / 2, KUP, 64 * (r / 32), 32 * (r % 32), scr, lane); continue; } r -= I1;
        if (r < I2) { transpose_item(a, 2, l, W + W_OUT / 2, 1024, 64 * (r / 32), 32 * (r % 32), scr, lane); continue; } r -= I2;
        if (r < I3) { transpose_item(a, 3, l, W + W_GU / 2, 1024, 64 * (r / 176), 32 * (r % 176), scr, lane); continue; } r -= I3;
        transpose_item(a, 4, l, W + W_DN / 2, DFF, 64 * (r / 32), 32 * (r % 32), scr, lane);
    }
}
__device__ __forceinline__ void ph_elem(const ElemArgs& a, int gw, int ngw, int lane) {
    for (int m = gw; m < M; m += ngw) {
        const int b = m / SEQ; const float* modb = a.modg + (size_t)b * 6144; const float* modnb = a.modn + (size_t)b * 6144;
        f32x4 v[4];
#pragma unroll
        for (int j = 0; j < 4; ++j) v[j] = *(const f32x4*)(a.xin + (size_t)m * DM + 256 * j + 4 * lane);
        if (a.do_res) {
            const f32x4 q0 = *(const f32x4*)(a.YSS + (size_t)m * 16), q1 = *(const f32x4*)(a.YSS + (size_t)m * 16 + 4), q2 = *(const f32x4*)(a.YSS + (size_t)m * 16 + 8), q3 = *(const f32x4*)(a.YSS + (size_t)m * 16 + 12);
            const float ss = (((q0[0] + q0[1]) + (q0[2] + q0[3])) + ((q1[0] + q1[1]) + (q1[2] + q1[3]))) + (((q2[0] + q2[1]) + (q2[2] + q2[3])) + ((q3[0] + q3[1]) + (q3[2] + q3[3])));
            const float rs = rsqrtf(ss * (1.f / DM) + RMS_EPS);
#pragma unroll
            for (int j = 0; j < 4; ++j) { const int c0 = 256 * j + 4 * lane;
                const uint2 yy = *(const uint2*)(a.Y + (size_t)m * DM + c0);
                const float y0 = __uint_as_float(yy.x << 16), y1 = __uint_as_float(yy.x & 0xffff0000u), y2 = __uint_as_float(yy.y << 16), y3 = __uint_as_float(yy.y & 0xffff0000u);
                const f32x4 gp = *(const f32x4*)(a.gpost + c0), gt = *(const f32x4*)(modb + a.gate_chunk * 1024 + c0);
                v[j][0] += gt[0] * (y0 * rs * gp[0]); v[j][1] += gt[1] * (y1 * rs * gp[1]); v[j][2] += gt[2] * (y2 * rs * gp[2]); v[j][3] += gt[3] * (y3 * rs * gp[3]); }
#pragma unroll
            for (int j = 0; j < 4; ++j) *(f32x4*)(a.xout + (size_t)m * DM + 256 * j + 4 * lane) = v[j];
        }
        if (a.do_norm) {
            float s = 0.f;
#pragma unroll
            for (int j = 0; j < 4; ++j) s += (v[j][0] * v[j][0] + v[j][1] * v[j][1]) + (v[j][2] * v[j][2] + v[j][3] * v[j][3]);
            const float rs = rsqrtf(wave_sum(s) * (1.f / DM) + RMS_EPS);
#pragma unroll
            for (int j = 0; j < 4; ++j) { const int c0 = 256 * j + 4 * lane;
                const f32x4 g = *(const f32x4*)(a.gpre + c0), sc = *(const f32x4*)(modnb + a.sc_chunk * 1024 + c0), sh = *(const f32x4*)(modnb + a.sh_chunk * 1024 + c0);
                float o[4];
#pragma unroll
                for (int e = 0; e < 4; ++e) o[e] = v[j][e] * rs * g[e] * (1.f + sc[e]) + sh[e];
                uint2 w; w.x = cvtpk(o[0], o[1]); w.y = cvtpk(o[2], o[3]);
                *(uint2*)(a.XN + (size_t)m * DM + c0) = w; }
        }
    }
}
__device__ __forceinline__ void ph_elem0(const ElemArgs& a, int gw, int ngw, int lane) {
    f32x4 v[4], v1[4], v2[4];
#pragma unroll
    for (int j = 0; j < 4; ++j) { v[j] = (f32x4){0.f, 0.f, 0.f, 0.f}; v1[j] = v[j]; v2[j] = v[j]; }
    if (gw < M) {
#pragma unroll
        for (int j = 0; j < 4; ++j) v[j] = *(const f32x4*)(a.xin + (size_t)gw * DM + 256 * j + 4 * lane); }
    if (gw + ngw < M) {
#pragma unroll
        for (int j = 0; j < 4; ++j) v1[j] = *(const f32x4*)(a.xin + (size_t)(gw + ngw) * DM + 256 * j + 4 * lane); }
#pragma unroll 1
    for (int m = gw; m < M; m += ngw) {
        const int m2 = m + 2 * ngw;
        if (m2 < M) {
#pragma unroll
            for (int j = 0; j < 4; ++j) v2[j] = *(const f32x4*)(a.xin + (size_t)m2 * DM + 256 * j + 4 * lane); }
        const int b = m / SEQ; const float* modnb = a.modn + (size_t)b * 6144;
        float s = 0.f;
#pragma unroll
        for (int j = 0; j < 4; ++j) s += (v[j][0] * v[j][0] + v[j][1] * v[j][1]) + (v[j][2] * v[j][2] + v[j][3] * v[j][3]);
        const float rs = rsqrtf(wave_sum(s) * (1.f / DM) + RMS_EPS);
#pragma unroll
        for (int j = 0; j < 4; ++j) { const int c0 = 256 * j + 4 * lane;
            const f32x4 g = *(const f32x4*)(a.gpre + c0), sc = *(const f32x4*)(modnb + a.sc_chunk * 1024 + c0), sh = *(const f32x4*)(modnb + a.sh_chunk * 1024 + c0);
            float o[4];
#pragma unroll
            for (int e = 0; e < 4; ++e) o[e] = v[j][e] * rs * g[e] * (1.f + sc[e]) + sh[e];
            uint2 w; w.x = cvtpk(o[0], o[1]); w.y = cvtpk(o[2], o[3]);
            *(uint2*)(a.XN + (size_t)m * DM + c0) = w; }
#pragma unroll
        for (int j = 0; j < 4; ++j) { v[j] = v1[j]; v1[j] = v2[j]; }
    }
}
__device__ __forceinline__ void unit_common(att::Unit& u, const MKArgs& a, int b) { u.posf = (const float*)(a.ws + WS_POSF) + (size_t)b * SEQ; u.K2 = nullptr; u.k2p = 0; u.lse = nullptr; u.lam = 0.f; u.cscale = 1.f; u.gdiff = nullptr; u.pmm = nullptr; u.kn0 = 0.f; u.kn1 = 0.f; u.hsplit = 0; u.slope2b = 0.f; u.m_initb = 0.f; u.r = 0; u.d = 1; u.n = SEQ; u.radius = 0; }
__device__ __forceinline__ void run_unit_a(const MKArgs& a, LAS unsigned char* lds, int br, int ua, const int tid) {
    const bf16_t* Z = (const bf16_t*)(a.ws + WS_ZH); bf16_t* OA = (bf16_t*)(a.ws + WS_Y); float* LSE = (float*)(a.ws + WS_LSE);
    const int bh = ua >> 4, sub = ua & 15, b = bh >> 2, h = bh & 3, d = br == 0 ? 1 : (br == 1 ? 4 : 16);
    att::Unit u; unit_common(u, a, b);
    u.d = d; u.n = SEQ / d; u.r = br == 0 ? 0 : (br == 1 ? (sub >> 2) : sub); const int qblk = br == 0 ? sub : (br == 1 ? (sub & 3) : 0);
    u.i0 = 256 * qblk; u.radius = 64; u.kbase = u.i0 - 64; u.ntiles = 6;
    const bf16_t* Zb = Z + (size_t)b * SEQ * NZ;
    u.Q = Zb + ZA_Q + 64 * h; u.qp = NZ; u.K1 = Zb + ZA_K + 64 * h; u.k1p = NZ; u.V = Zb + ZA_V + 64 * h; u.vp = NZ;
    u.slope2 = alibi_slope(9 + h) * LOG2E; u.m_init = -1e20f; u.l_init = 0.f;
    u.O = OA + ((size_t)br * M + (size_t)b * SEQ) * 256 + 64 * h; u.op = 256; u.lse = LSE + ((size_t)br * M + (size_t)b * SEQ) * 4 + h;
    att::attn_unit<0>(u, lds, tid);
}
__device__ __forceinline__ void run_unit_b(const MKArgs& a, LAS unsigned char* lds, int l, int ub, const int tid) {
    const bf16_t* Z = (const bf16_t*)(a.ws + WS_ZH); bf16_t* MIX = (bf16_t*)(a.ws + WS_MIX);
    const int bg = ub >> 5, qblk = ub & 31, b = bg >> 1, g = bg & 1, h = 2 * g;
    att::Unit u; unit_common(u, a, b);
    u.i0 = 128 * qblk; u.radius = 128; u.kbase = u.i0 - 128; u.ntiles = 6; u.hsplit = 1;
    const bf16_t* Zb = Z + (size_t)b * SEQ * NZ;
    u.Q = Zb + ZB_Q + 64 * h; u.qp = NZ; u.K1 = Zb + ZB_K + 64 * g; u.k1p = NZ; u.V = Zb + ZB_V + 64 * g; u.vp = NZ;
    u.slope2 = alibi_slope(1 + h) * LOG2E; u.m_init = a.in[8][l * 4 + h] * LOG2E; u.l_init = 1.f;
    u.slope2b = alibi_slope(2 + h) * LOG2E; u.m_initb = a.in[8][l * 4 + h + 1] * LOG2E;
    u.O = MIX + (size_t)b * SEQ * DM + 256 + 64 * h; u.op = DM;
    att::attn_unit<0>(u, lds, tid);
}
__device__ __forceinline__ void run_unit_c(const MKArgs& a, LAS unsigned char* lds, int l, int uc, const int tid) {
    const bf16_t* Z = (const bf16_t*)(a.ws + WS_ZH); bf16_t* MIX = (bf16_t*)(a.ws + WS_MIX);
    const int bh = uc >> 4, qblk = uc & 15, b = bh >> 2, h = bh & 3;
    att::Unit u; unit_common(u, a, b);
    u.i0 = 256 * qblk; u.kbase = 0; u.ntiles = SEQ / 64;
    const bf16_t* Zb = Z + (size_t)b * SEQ * NZ;
    u.Q = Zb + ZC_Q + 64 * h; u.qp = NZ; u.K1 = Zb + ZC_K + 64 * h; u.k1p = NZ; u.V = Zb + ZC_V + 64 * h; u.vp = NZ;
    u.slope2 = alibi_slope(5 + h) * LOG2E; u.m_init = -1e20f; u.l_init = 0.f;
    const int li_ = tid & 31;
    const float d1 = wave_sum(a.in[9][l * 32 + li_] * a.in[10][l * 32 + li_]) * 0.5f, d2 = wave_sum(a.in[11][l * 32 + li_] * a.in[12][l * 32 + li_]) * 0.5f;
    const float lam_init = 0.8f - 0.6f * expf(-0.3f * (float)l);
    u.lam = expf(d1) - expf(d2) + lam_init; u.cscale = 1.f - lam_init; u.gdiff = a.in[13] + l * 64;
    u.O = MIX + (size_t)b * SEQ * DM + 512 + 64 * h; u.op = DM;
    { const unsigned* KMAX = (const unsigned*)(a.ws + WS_CTL) + CW_KMAX + (b * 4 + h) * 2; u.pmm = (const float*)(a.ws + WS_PMM) + (size_t)b * 128;
      u.kn0 = sqrtf(__uint_as_float(KMAX[0])) * 1.02f; u.kn1 = sqrtf(__uint_as_float(KMAX[1])) * 1.02f; }
    att::attn_unit<1>(u, lds, tid);
}
__device__ __forceinline__ void run_unit_d(const MKArgs& a, LAS unsigned char* lds, int ud, const int tid) {
    const bf16_t* Z = (const bf16_t*)(a.ws + WS_ZH); bf16_t* MIX = (bf16_t*)(a.ws + WS_MIX); const bf16_t* KV = (const bf16_t*)(a.ws + WS_KV); const bf16_t* QD = (const bf16_t*)(a.ws + WS_QD);
    const int bh = ud >> 4, qblk = ud & 15, b = bh >> 2, h = bh & 3;
    att::Unit u; unit_common(u, a, b);
    u.i0 = 256 * qblk; u.kbase = 0; u.ntiles = SEQ / 64;
    const size_t rb = (size_t)b * SEQ;
    u.Q = QD + rb * 384 + 96 * h; u.qp = 384; u.K1 = KV + rb * 512 + 128 * h; u.k1p = 512; u.K2 = Z + rb * NZ + ZD_KR; u.k2p = NZ; u.V = KV + rb * 512 + 128 * h + 64; u.vp = 512;
    u.slope2 = 0.f; u.m_init = -1e20f; u.l_init = 0.f;
    u.O = MIX + rb * DM + 768 + 64 * h; u.op = DM;
    att::attn_unit_d16(u, lds, tid);
}
__device__ __forceinline__ void ph_merge_a(const MKArgs& a, int gtid, int gthreads) {
    const bf16_t* OA = (const bf16_t*)(a.ws + WS_Y); const float* LSE = (const float*)(a.ws + WS_LSE); bf16_t* MIX = (bf16_t*)(a.ws + WS_MIX);
    for (int idx = gtid; idx < M * 32; idx += gthreads) { const size_t row = idx >> 5; const int ch = idx & 31, h = ch >> 3;
        const float l0 = LSE[row * 4 + h], l1 = LSE[((size_t)M + row) * 4 + h], l2 = LSE[((size_t)2 * M + row) * 4 + h];
        const float mx = fmaxf(l0, fmaxf(l1, l2)); float w0 = exp2f(l0 - mx), w1 = exp2f(l1 - mx), w2 = exp2f(l2 - mx); const float inv = 1.f / (w0 + w1 + w2); w0 *= inv; w1 *= inv; w2 *= inv;
        const u32x4 x0 = *(const u32x4*)(OA + row * 256 + 8 * ch), x1 = *(const u32x4*)(OA + ((size_t)M + row) * 256 + 8 * ch), x2 = *(const u32x4*)(OA + ((size_t)2 * M + row) * 256 + 8 * ch);
        u32x4 o;
#pragma unroll
        for (int e = 0; e < 4; ++e) { const float lo = w0 * __uint_as_float(x0[e] << 16) + w1 * __uint_as_float(x1[e] << 16) + w2 * __uint_as_float(x2[e] << 16);
            const float hi = w0 * __uint_as_float(x0[e] & 0xffff0000u) + w1 * __uint_as_float(x1[e] & 0xffff0000u) + w2 * __uint_as_float(x2[e] & 0xffff0000u); o[e] = cvtpk(lo, hi); }
        *(u32x4*)(MIX + row * DM + 8 * ch) = o; }
}

__global__ void __launch_bounds__(NTHREADS, 2) mk_fwd(MKArgs a) {
    extern __shared__ __attribute__((aligned(16))) unsigned char lds_raw[];
    LAS unsigned char* lds = (LAS unsigned char*)lds_raw;
    const int wid0 = __builtin_amdgcn_readfirstlane((int)(threadIdx.x >> 6));
    const int G = gridDim.x, bid = blockIdx.x, vcu = (G % 8 == 0) ? (bid % 8) * (G / 8) + bid / 8 : bid;
    unsigned char* ws = a.ws;
    float* MOD = (float*)(ws + WS_MOD); float* COS = (float*)(ws + WS_COS); float* SIN = (float*)(ws + WS_SIN); float* SS = (float*)(ws + WS_SS); float* YSS = (float*)(ws + WS_YSS);
    bf16_t* XN = (bf16_t*)(ws + WS_XN); bf16_t* ZH = (bf16_t*)(ws + WS_ZH); bf16_t* KV = (bf16_t*)(ws + WS_KV); bf16_t* QD = (bf16_t*)(ws + WS_QD); bf16_t* MIX = (bf16_t*)(ws + WS_MIX); bf16_t* Y = (bf16_t*)(ws + WS_Y);
    const float* x = a.in[0]; float* out = a.out;
    const int ngw = G * NWAVES;
    volatile LAS unsigned* MISC = (volatile LAS unsigned*)(lds + MISC_OFF);
    for (int u = threadIdx.x; u < 64; u += NTHREADS) MISC[u] = 0u;
    __syncthreads();
    XcdBarrier bar; bar.bar = (unsigned*)(ws + WS_CTL) + CW_BAR; bar.x = 0; bar.st = nullptr;
    if (a.ph_hi - a.ph_lo > 1) bar = xcd_barrier_post((unsigned*)(ws + WS_CTL) + CW_BAR, MISC + 8);
    for (int ph = a.ph_lo; ph < a.ph_hi; ++ph) {
        int tid; asm volatile("v_mbcnt_lo_u32_b32 %0, -1, 0\n\tv_mbcnt_hi_u32_b32 %0, -1, %0" : "=v"(tid)); tid += wid0 * 64;
        const int lane = tid & 63, wid = __builtin_amdgcn_readfirstlane(tid >> 6), gw = vcu * NWAVES + wid;
        if (ph == 0) { if (EN(8)) ph_prologue(a, lds, bid, G, tid); }
        else if (ph == 1) { if (EN(9)) { ElemArgs e{x, out, nullptr, nullptr, nullptr, MOD, 0, a.in[5], MOD, 1, 0, XN, 0, 1}; ph_elem0(e, gw, ngw, lane); ph_wconv(a, lds, bid, G, tid, 0, (WCONV_SPLIT && G == 256) ? 1 : DEPTH); } }
        else {
            const int l = (ph - 2) >> 3, st = (ph - 2) & 7;
            if (FUSE_E && (st == 4 || st == 7)) continue;
            const int xmask = a.xmask, ymask = a.ymask;
            const bf16_t* W = (const bf16_t*)(ws + WS_W + (size_t)l * W_LAYER); const float* modl = MOD + (size_t)l * 8 * 6144;
            pg8::StaticOrder S;
            const bool pjq = XQUEUE && a.xmask == 15 && (G & 7) == 0 && (G / 8) % PJ_DIV == 0, pjrole = !pjq || ((bid >> 3) % PJ_DIV == 0);
            const int pjG = pjq ? G / PJ_DIV : G, pjc = pjq ? ((bid >> 3) / PJ_DIV) * 8 + (bid & 7) : bid;
            if (st == 0 || (KRSPLIT && st == 1 && (xmask & 1) && pjrole)) { if (EN(0)) { const bool kr = (st == 1);
                pg8::Gemm g{XN, W + W_IN / 2 + (kr ? (size_t)2560 * DM : (size_t)0), M, KRSPLIT ? (kr ? 256 : 2560) : NZ, DM, DM, 0}; S.init(M, g.N, kr ? pjG : G, kr ? pjc : bid); EpiZ E{ZH, SS, COS, SIN, (unsigned*)(ws + WS_CTL) + CW_KMAX, kr ? 10 : 0}; pg8::gemm_phase<EpiZ, true>(lds, g, S, E, tid);
                if (WCONV_SPLIT && l == 0 && G == 256 && bid >= 128) ph_wconv(a, lds, bid - 128, 128, tid, 1, DEPTH); } }
            if (st == 1) {
                if (EN(1) && (xmask & 1) && pjrole) { pg8::Gemm g{ZH + ZD_CQ, W + W_UP / 2, M, NUP, KUP, NZ, 1}; S.init(M, NUP, pjG, pjc); EpiUp E{KV, QD, SS, COS, SIN}; pg8::gemm_phase<EpiUp, true>(lds, g, S, E, tid); }
                if (XQUEUE && xmask == 15 && (G & 7) == 0) {
                    const int qx = bid & 7, b = qx; unsigned* ctr = (unsigned*)(ws + WS_CTL) + CW_QUEUE + (l * 8 + qx) * 64;
                    unsigned nreg = 0u; if (tid == 0) nreg = atomicAdd(ctr, 1u);
                    if (tid == 0) MISC[16] = nreg;
                    __syncthreads(); int it = (int)MISC[16]; __syncthreads();
                    while (it < 320) {
                        if (tid == 0) nreg = atomicAdd(ctr, 1u);
                        if (it < 64) { const int h = 3 - (it >> 4), qb = it & 15; run_unit_c(a, lds, l, ((b * 4 + h) << 4) + qb, tid); }
                        else if (it < 128) { const int j = it - 64; run_unit_b(a, lds, l, ((b * 2 + (j >> 5)) << 5) + (j & 31), tid); }
                        else { const int j = it - 128, br = j >> 6, rem = j & 63; run_unit_a(a, lds, br, ((b * 4 + (rem >> 4)) << 4) + (rem & 15), tid); }
                        if (tid == 0) MISC[16] = nreg;
                        __syncthreads(); it = (int)MISC[16]; __syncthreads();
                    }
                } else {
                if (EN(12) && (xmask & 8)) for (int u = vcu; u < 512; u += G) run_unit_c(a, lds, l, u < 256 ? u : (u ^ 48), tid);
                if (EN(11) && (xmask & 4)) for (int u = vcu; u < 512; u += G) run_unit_b(a, lds, l, u, tid);
                if (EN(10) && (xmask & 2)) for (int br = 0; br < 3; ++br) for (int u = vcu; u < 512; u += G) run_unit_a(a, lds, br, u, tid);
                }
            }
            else if (st == 2) {
                const int nu = vcu < 512 ? (512 - vcu + G - 1) / G : 0, mpos = (bid % 3) < nu ? (bid % 3) : nu;
                for (int k = 0; k <= nu; ++k) {
                    if (k == mpos && EN(13) && (ymask & 2)) ph_merge_a(a, vcu * NTHREADS + tid, G * NTHREADS);
                    if (k < nu && EN(2) && (ymask & 1)) run_unit_d(a, lds, vcu + k * G, tid); }
            }
            else if (st == 3) { if (EN(3)) { pg8::Gemm g{MIX, W + W_OUT / 2, M, DM, DM, DM, 0}; S.init(M, DM, G, bid);
                if (FUSE_E) { unsigned* cnt = (unsigned*)(ws + WS_CTL) + CW_CNT + (l * 4) * 8192; unsigned* slot = (unsigned*)YSS;
                    EpiFused E{l == 0 ? x : out, out, XN, a.in[6] + l * DM, modl, 2, a.in[19] + l * DM, modl, 4, 3, RowStat{slot, cnt}, RowStat{slot + (size_t)M * 4, cnt + 8192}, 1};
                    pg8::gemm_phase<EpiFused, true>(lds, g, S, E, tid); }
                else { EpiY E{Y, YSS}; pg8::gemm_phase<EpiY, true>(lds, g, S, E, tid); } } }
            else if (st == 4) { ElemArgs e{l == 0 ? x : out, out, Y, YSS, a.in[6] + l * DM, modl, 2, a.in[19] + l * DM, modl, 4, 3, XN, 1, 1}; ph_elem(e, gw, ngw, lane); }
            else if (st == 5) { if (EN(5)) { pg8::Gemm g{XN, W + W_GU / 2, M, NGU, DM, DM, 0}; S.init(M, NGU, G, bid); EpiH E{ZH}; pg8::gemm_phase<EpiH, true>(lds, g, S, E, tid); } }
            else if (st == 6) { if (EN(6)) { pg8::Gemm g{ZH, W + W_DN / 2, M, DM, DFF, DFF, 0}; S.init(M, DM, G, bid);
                if (FUSE_E) { const int ln = l + 1 < DEPTH ? l + 1 : l; unsigned* cnt = (unsigned*)(ws + WS_CTL) + CW_CNT + (l * 4 + 2) * 8192; unsigned* slot = (unsigned*)YSS;
                    EpiFused E{out, out, XN, a.in[20] + l * DM, modl, 5, a.in[5] + ln * DM, MOD + (size_t)ln * 8 * 6144, 1, 0, RowStat{slot, cnt}, RowStat{slot + (size_t)M * 4, cnt + 8192}, l + 1 < DEPTH ? 1 : 0};
                    pg8::gemm_phase<EpiFused, true>(lds, g, S, E, tid); }
                else { EpiY E{Y, YSS}; pg8::gemm_phase<EpiY, true>(lds, g, S, E, tid); } } }
            else if (st == 7) { const int ln = l + 1 < DEPTH ? l + 1 : l;
                ElemArgs e{out, out, Y, YSS, a.in[20] + l * DM, modl, 5, a.in[5] + ln * DM, MOD + (size_t)ln * 8 * 6144, 1, 0, XN, 1, l + 1 < DEPTH ? 1 : 0}; ph_elem(e, gw, ngw, lane); }
        }
        if (ph + 1 < a.ph_hi && !(FUSE_E && ph == NPH - 2)) { if (a.ph_lo < 0) cg::this_grid().sync(); else { int tb; asm volatile("v_mbcnt_lo_u32_b32 %0, -1, 0\n\tv_mbcnt_hi_u32_b32 %0, -1, %0" : "=v"(tb)); tb += wid0 * 64; xcd_barrier(bar, tb); } }
    }
}
extern "C" void kernel_launch(void* const* d_in, const int* in_sizes, int n_in, void* d_out, int out_size, void* d_ws, size_t ws_size, hipStream_t stream) {
    if (n_in != 23 || out_size != M * DM || ws_size < WS_END) { fprintf(stderr, "kernel_launch: unexpected shapes (n_in %d out %d ws %zu)\n", n_in, out_size, ws_size); return; }
    static int grid = 0;
    if (grid == 0) {
        int dev = 0, cus = 0, per_cu = 0;
        hipGetDevice(&dev); hipDeviceGetAttribute(&cus, hipDeviceAttributeMultiprocessorCount, dev);
        if (hipFuncSetAttribute((const void*)mk_fwd, hipFuncAttributeMaxDynamicSharedMemorySize, LDS_TOTAL) != hipSuccess) { fprintf(stderr, "kernel_launch: hipFuncSetAttribute failed\n"); grid = -1; return; }
        if (hipOccupancyMaxActiveBlocksPerMultiprocessor(&per_cu, (const void*)mk_fwd, NTHREADS, LDS_TOTAL) != hipSuccess || per_cu < 1) { fprintf(stderr, "kernel_launch: occupancy query says %d\n", per_cu); per_cu = 1; }
        (void)hipGetLastError();
        grid = cus * 1;
    }
    if (grid < 0) return;
    unsigned char* ws = (unsigned char*)d_ws; float* out = (float*)d_out;
    MKArgs a{};
    for (int i = 0; i < 23; ++i) a.in[i] = (const float*)d_in[i];
    a.out = out; a.ws = ws; a.xmask = 15; a.ymask = 3;
    if (hipMemsetAsync(ws + WS_CTL, 0, CTL_ZERO_BYTES, stream) != hipSuccess) { fprintf(stderr, "kernel_launch: memset failed\n"); return; }
    {
        a.ph_lo = 0; a.ph_hi = NPH; void* args[] = {&a};
        hipError_t e = hipLaunchCooperativeKernel((const void*)mk_fwd, dim3(grid), dim3(NTHREADS), args, LDS_TOTAL, stream);
        if (e != hipSuccess) fprintf(stderr, "cooperative launch failed: %s (grid %d)\n", hipGetErrorString(e), grid);
        return;
    }
}
```

```cpp
#include <hip/hip_runtime.h>
#include <cstdio>
#include <cstdint>

typedef unsigned short bf16_t;
typedef unsigned u32x4 __attribute__((ext_vector_type(4)));
typedef float f32x4 __attribute__((ext_vector_type(4)));

constexpr int BATCH = 8, SEQ = 4096, DM = 1024, DEPTH = 2, M = BATCH * SEQ;
constexpr int IN_W = 2592, NZ = 2816, DFF = 2816, NGU = 5632;
constexpr int NUP = 1024, KUP = 512;
constexpr float RMS_EPS = 1e-6f;
constexpr float LOG2E = 1.4426950408889634f;
constexpr int ZA_Q = 0, ZA_K = 256, ZA_V = 512, ZB_Q = 768, ZB_K = 1024, ZB_V = 1152, ZC_Q = 1280, ZC_K = 1536, ZC_V = 1792, ZD_CQ = 2048, ZD_CKV = 2432, ZD_KR = 2560;

constexpr size_t MiB = 1u << 20;
constexpr size_t WS_CTL = 0;
constexpr size_t WS_MOD = 1 * MiB;
constexpr size_t WS_COS = 2 * MiB, WS_SIN = 4 * MiB;
constexpr size_t WS_SS = 6 * MiB;
constexpr size_t WS_YSS = 8 * MiB;
constexpr size_t WS_LSE = 10 * MiB;
constexpr size_t WS_POSF = 1 * MiB + 512 * 1024;
constexpr size_t WS_PMM = 11 * MiB + 512 * 1024;
constexpr size_t WS_W = 12 * MiB;
constexpr size_t W_IN = 0, W_UP = 5632 * 1024, W_OUT = W_UP + 1 * MiB, W_GU = W_OUT + 2 * MiB, W_DN = W_GU + 11 * MiB, W_LAYER = 25 * MiB;
constexpr size_t WS_XN = 62 * MiB;
constexpr size_t WS_ZH = 126 * MiB;
constexpr size_t WS_KV = 302 * MiB;
constexpr size_t WS_QD = 334 * MiB;
constexpr size_t WS_MIX = 358 * MiB;
constexpr size_t WS_Y = 422 * MiB;
constexpr size_t WS_END = 486 * MiB;

__device__ __forceinline__ float bf2f(bf16_t v) { return __uint_as_float(((unsigned)v) << 16); }
__device__ __forceinline__ bf16_t f2bf(float f) { unsigned u = __float_as_uint(f); return (bf16_t)((u + 0x7fffu + ((u >> 16) & 1u)) >> 16); }
__device__ __forceinline__ float wave_sum(float v) {
#pragma unroll
    for (int o = 1; o < 64; o <<= 1) v += __shfl_xor(v, o);
    return v;
}
__host__ __device__ __forceinline__ float alibi_slope(int j  ) { return exp2f(-8.0f * (float)j / 12.0f); }

struct ElemArgs { const float* xin; float* xout; const bf16_t* Y; const float* YSS; const float* gpost; const float* modg; int gate_chunk; const float* gpre; const float* modn; int sc_chunk, sh_chunk; bf16_t* XN; int do_res, do_norm; };

#define LAS __attribute__((address_space(3)))
typedef short bf16x8 __attribute__((ext_vector_type(8)));
typedef float f32x16 __attribute__((ext_vector_type(16)));
typedef float f32x2 __attribute__((ext_vector_type(2)));
typedef int i32x4 __attribute__((ext_vector_type(4)));
typedef __bf16 bf16x2_t __attribute__((ext_vector_type(2)));
typedef short s16x4 __attribute__((ext_vector_type(4)));
__device__ __forceinline__ unsigned cvtpk(float lo, float hi) { f32x2 v = {lo, hi}; bf16x2_t b = __builtin_convertvector(v, bf16x2_t); return __builtin_bit_cast(unsigned, b); }
__device__ __forceinline__ u32x4 pack8(const f32x4& a, const f32x4& b) { u32x4 w; w.x = cvtpk(a[0], a[1]); w.y = cvtpk(a[2], a[3]); w.z = cvtpk(b[0], b[1]); w.w = cvtpk(b[2], b[3]); return w; }

namespace pg8 {
constexpr int BM = 256, BK = 64, HALF = 128, HTB = HALF * BK * 2, STAGE_BYTES = 8 * HTB, NXCD = 8, WGM = 8;
__host__ __device__ __forceinline__ int lds_byte(int r, int c) { const int st = (r >> 4) * 2 + (c >> 5), rr = r & 15, cc = c & 31, ob = rr * 64 + cc * 2; return st * 1024 + (ob ^ (((ob >> 9) & 1) << 5)); }
__host__ __device__ __forceinline__ void stage_rc(int b, int& R, int& C) { const int st = b / 1024, sb = b % 1024, swz = sb ^ (((sb >> 9) & 1) << 5); R = (st >> 1) * 16 + swz / 64; C = (st & 1) * 32 + (swz % 64) / 2; }
__host__ __device__ __forceinline__ int perm32(int rho) { const int n = rho >> 4, i = rho & 15; return 8 * (i >> 2) + 4 * n + (i & 3); }
struct Unit { int pm, pn; };
struct Gemm { const bf16_t* A; const bf16_t* Bt; int M, N, K, lda, ksplit; };
struct StaticOrder {
    int nM, nN, nwg, G, c;
    __device__ void init(int M_, int N_, int G_, int c_) { nM = M_ / BM; nN = N_ / BM; nwg = nM * nN; G = G_; c = c_; }
    __device__ bool next(int i, Unit& u) const {
        const long L = (long)i * G + c; if (L >= nwg) return false;
        int wgid = (int)L; { const int q = nwg / NXCD, r = nwg % NXCD, xcd = wgid % NXCD, off = wgid / NXCD; wgid = (xcd < r ? xcd * (q + 1) : r * (q + 1) + (xcd - r) * q) + off; }
        const int nig = WGM * nN, gid = wgid / nig, fm = gid * WGM, gsz = (nM - fm) < WGM ? (nM - fm) : WGM;
        u.pm = fm + ((wgid % nig) % gsz); u.pn = (wgid % nig) / gsz; return true;
    }
};
template <class Epi, bool ALIGN_EPI>
__device__ __forceinline__ void gemm_phase(LAS unsigned char* lds, const Gemm g, const StaticOrder& S, const Epi& E, const int tid) {
    const int wid = __builtin_amdgcn_readfirstlane(tid >> 6), lane = tid & 63, wr = wid >> 2, wc = wid & 3, fr = lane & 15, fq = lane >> 4;
    const int K = g.K, lda = g.lda; int nt = K / BK;
    unsigned voffA[2], voffB[2];
#pragma unroll
    for (int i = 0; i < 2; ++i) { int R, C; stage_rc(tid * 16 + i * 8192, R, C); const int Rb = (R & ~31) + perm32(R & 31);
        voffA[i] = (unsigned)(R * lda + C) * 2u; voffB[i] = (unsigned)(Rb * K + C) * 2u; }
    const size_t kstep = (size_t)(BK * 2);
    const size_t hstepA = (size_t)HALF * lda * 2, hstepB = (size_t)HALF * K * 2, tstepA = 2 * hstepA, tstepB = 2 * hstepB;
    const unsigned ldsw = (unsigned)wid * 1024u;
    const int aoff = lds_byte(wr * 64 + fr, fq * 8), boff = lds_byte(wc * 32 + fr, fq * 8);
#define PG8_SA(b, h) (((b) * 2 + (h)) * HTB)
#define PG8_SB(b, h) ((4 + (b) * 2 + (h)) * HTB)
#define PG8_STAGE(bufoff, gbase, voff) do { _Pragma("unroll") for (int _i = 0; _i < 2; ++_i) \
        __builtin_amdgcn_global_load_lds((const unsigned*)((const char*)(gbase) + (voff)[_i]), (LAS unsigned*)(lds + (bufoff) + ldsw + _i * 8192), 16, 0, 0); } while (0)
#define PG8_LDA(dst, b, h) do { _Pragma("unroll") for (int m = 0; m < 4; ++m) _Pragma("unroll") for (int k = 0; k < 2; ++k) dst[m][k] = *(const LAS bf16x8*)(lds + PG8_SA(b, h) + aoff + m * 2048 + k * 1024); } while (0)
#define PG8_LDB(dst, b, h) do { _Pragma("unroll") for (int n = 0; n < 2; ++n) _Pragma("unroll") for (int k = 0; k < 2; ++k) dst[n][k] = *(const LAS bf16x8*)(lds + PG8_SB(b, h) + boff + n * 2048 + k * 1024); } while (0)
#define PG8_MMA(ai, bj, At, Bt) do { __builtin_amdgcn_s_setprio(1); _Pragma("unroll") for (int m = 0; m < 4; ++m) _Pragma("unroll") for (int n = 0; n < 2; ++n) _Pragma("unroll") for (int k = 0; k < 2; ++k) \
        acc[ai][bj][m][n] = __builtin_amdgcn_mfma_f32_16x16x32_bf16(Bt[n][k], At[m][k], acc[ai][bj][m][n], 0, 0, 0); __builtin_amdgcn_s_setprio(0); } while (0)
#define PG8_WAIT_V(n) asm volatile("s_waitcnt vmcnt(" #n ")" ::: "memory")
#define PG8_WAIT_L(n) asm volatile("s_waitcnt lgkmcnt(" #n ")" ::: "memory")
#define PG8_BAR __builtin_amdgcn_s_barrier()
#define PG8_SCHED __builtin_amdgcn_sched_barrier(0)
    Unit cur, nxt; int ui = 0;
    if (!S.next(0, cur)) return;
    f32x4 acc[2][2][4][2];
#pragma unroll
    for (int a = 0; a < 2; ++a)
#pragma unroll
        for (int b = 0; b < 2; ++b)
#pragma unroll
            for (int m = 0; m < 4; ++m)
#pragma unroll
                for (int n = 0; n < 2; ++n) acc[a][b][m][n] = (f32x4){0.f, 0.f, 0.f, 0.f};
    bf16x8 At[4][2], B0[2][2], B1[2][2];
#define PG8_KBEG(u_) (g.ksplit ? ((u_).pn < 2 ? 512 : 0) : 0)
#define PG8_KNT(u_) (g.ksplit ? ((u_).pn < 2 ? 4 : 6) : K / BK)
    const char* cA = (const char*)g.A + (size_t)cur.pm * tstepA + PG8_KBEG(cur); const char* cB = (const char*)g.Bt + (size_t)cur.pn * tstepB + PG8_KBEG(cur); nt = PG8_KNT(cur);
    PG8_STAGE(PG8_SB(0, 0), cB, voffB); PG8_STAGE(PG8_SB(0, 1), cB + hstepB, voffB); PG8_STAGE(PG8_SA(0, 0), cA, voffA); PG8_STAGE(PG8_SA(0, 1), cA + hstepA, voffA);
    if (wr == 1) PG8_BAR;
    PG8_WAIT_V(2); PG8_BAR;
    PG8_STAGE(PG8_SB(1, 0), cB + kstep, voffB); PG8_STAGE(PG8_SA(1, 0), cA + kstep, voffA); PG8_STAGE(PG8_SB(1, 1), cB + hstepB + kstep, voffB);
    PG8_WAIT_V(6); PG8_BAR;
    for (;;) {
        const bool has_next = S.next(ui + 1, nxt);
        const char* nA = has_next ? (const char*)g.A + (size_t)nxt.pm * tstepA + PG8_KBEG(nxt) : cA; const char* nB = has_next ? (const char*)g.Bt + (size_t)nxt.pn * tstepB + PG8_KBEG(nxt) : cB;
        for (int t = 0; t < nt; t += 2) {
            const bool last = (t == nt - 2);
            const char* a1 = cA + (size_t)(t + 1) * kstep;
            const char* a2 = last ? nA : cA + (size_t)(t + 2) * kstep; const char* b2 = last ? nB : cB + (size_t)(t + 2) * kstep;
            const char* a3 = a2 + kstep; const char* b3 = b2 + kstep;
            PG8_LDB(B0, 0, 0); PG8_LDB(B1, 0, 1); PG8_SCHED; PG8_LDA(At, 0, 0); PG8_STAGE(PG8_SA(1, 1), a1 + hstepA, voffA);
            PG8_WAIT_V(8); PG8_WAIT_L(0); PG8_BAR; PG8_MMA(0, 0, At, B0); PG8_MMA(0, 1, At, B1); PG8_BAR; PG8_SCHED;
            PG8_LDA(At, 0, 1); PG8_STAGE(PG8_SB(0, 0), b2, voffB); PG8_STAGE(PG8_SB(0, 1), b2 + hstepB, voffB); PG8_STAGE(PG8_SA(0, 0), a2, voffA);
            PG8_WAIT_V(8); PG8_WAIT_L(0); PG8_BAR; PG8_MMA(1, 0, At, B0); PG8_MMA(1, 1, At, B1); PG8_BAR; PG8_SCHED;
            PG8_LDB(B0, 1, 0); PG8_LDB(B1, 1, 1); PG8_SCHED; PG8_LDA(At, 1, 0); PG8_STAGE(PG8_SA(0, 1), a2 + hstepA, voffA);
            PG8_WAIT_V(8); PG8_WAIT_L(0); PG8_BAR; PG8_MMA(0, 0, At, B0); PG8_MMA(0, 1, At, B1); PG8_BAR; PG8_SCHED;
            PG8_LDA(At, 1, 1); PG8_STAGE(PG8_SB(1, 0), b3, voffB); PG8_STAGE(PG8_SB(1, 1), b3 + hstepB, voffB); PG8_STAGE(PG8_SA(1, 0), a3, voffA);
            PG8_WAIT_V(8); PG8_WAIT_L(0); PG8_BAR; PG8_MMA(1, 0, At, B0); PG8_MMA(1, 1, At, B1); PG8_BAR; PG8_SCHED;
        }
        if constexpr (ALIGN_EPI) { if (wr == 0) PG8_BAR; }
        if constexpr (Epi::FUSED) E.fused(acc, cur, wr, wc, fr, fq, lds, wid, lane, tid); else E(acc, cur, wr, wc, fr, fq);
        if (!has_next) break;
#pragma unroll
        for (int a = 0; a < 2; ++a)
#pragma unroll
            for (int b = 0; b < 2; ++b)
#pragma unroll
                for (int m = 0; m < 4; ++m)
#pragma unroll
                    for (int n = 0; n < 2; ++n) acc[a][b][m][n] = (f32x4){0.f, 0.f, 0.f, 0.f};
        cur = nxt; cA = nA; cB = nB; ++ui; nt = PG8_KNT(cur);
        if constexpr (ALIGN_EPI) { if (wr == 1) PG8_BAR; }
    }
    PG8_WAIT_V(0);
    if constexpr (!ALIGN_EPI) { if (wr == 0) PG8_BAR; }
    PG8_BAR;
#undef PG8_KBEG
#undef PG8_KNT
#undef PG8_SA
#undef PG8_SB
#undef PG8_STAGE
#undef PG8_LDA
#undef PG8_LDB
#undef PG8_MMA
#undef PG8_WAIT_V
#undef PG8_WAIT_L
#undef PG8_BAR
#undef PG8_SCHED
}
}

__device__ __forceinline__ float sumsq8(const f32x4& a, const f32x4& b) { return ((a[0] * a[0] + a[1] * a[1]) + (a[2] * a[2] + a[3] * a[3])) + ((b[0] * b[0] + b[1] * b[1]) + (b[2] * b[2] + b[3] * b[3])); }
__device__ __forceinline__ void rope8(f32x4& v0, f32x4& v1, const float* cosr, const float* sinr, int fq) {
    const int i0 = 8 * (fq & 1);
    const f32x4 c0 = *(const f32x4*)(cosr + i0), c1 = *(const f32x4*)(cosr + i0 + 4), s0 = *(const f32x4*)(sinr + i0), s1 = *(const f32x4*)(sinr + i0 + 4);
    f32x4 p0, p1;
#pragma unroll
    for (int e = 0; e < 4; ++e) { p0[e] = __shfl_xor(v0[e], 32); p1[e] = __shfl_xor(v1[e], 32); }
    if (fq < 2) { v0 = v0 * c0 - p0 * s0; v1 = v1 * c1 - p1 * s1; }
    else        { v0 = p0 * s0 + v0 * c0; v1 = p1 * s1 + v1 * c1; }
}
struct EpiZ {
    static constexpr bool FUSED = false;
    bf16_t* Z; float* SS; const float* cosT; const float* sinT; unsigned* KMAX; int pn_off;
    __device__ __forceinline__ void operator()(const f32x4 (&acc)[2][2][4][2], const pg8::Unit& u_, int wr, int wc, int fr, int fq) const {
        pg8::Unit u = u_; u.pn += pn_off;
        const int row0 = u.pm * 256 + wr * 64 + fr, colb = u.pn * 256 + wc * 32 + 8 * fq;
        const bool rope = (u.pn == 10) && (wc == 0), ssq = (u.pn == 8) || (u.pn == 9);
#pragma unroll
        for (int ai = 0; ai < 2; ++ai)
#pragma unroll
            for (int m = 0; m < 4; ++m) { const int row = row0 + ai * 128 + m * 16;
                f32x4 a0 = acc[ai][0][m][0], a1 = acc[ai][0][m][1]; const f32x4 b0 = acc[ai][1][m][0], b1 = acc[ai][1][m][1];
                if (rope) rope8(a0, a1, cosT + (size_t)row * 16, sinT + (size_t)row * 16, fq);
                *(u32x4*)(Z + (size_t)row * NZ + colb) = pack8(a0, a1);
                *(u32x4*)(Z + (size_t)row * NZ + colb + 128) = pack8(b0, b1);
                if (ssq) { float s0 = sumsq8(a0, a1), s1 = sumsq8(b0, b1);
                    s0 += __shfl_xor(s0, 16); s0 += __shfl_xor(s0, 32); s1 += __shfl_xor(s1, 16); s1 += __shfl_xor(s1, 32);
                    if (fq == 0) { if (u.pn == 8) SS[(size_t)row * 12 + wc] = s0 + s1; else { SS[(size_t)row * 12 + 4 + wc] = s0; SS[(size_t)row * 12 + 8 + wc] = s1; } } }
                asm volatile("" ::: "memory");
            }
        if (u.pn == 6) {
            float mx0 = 0.f, mx1 = 0.f;
#pragma unroll
            for (int ai = 0; ai < 2; ++ai)
#pragma unroll
                for (int m = 0; m < 4; ++m) { float s0 = sumsq8(acc[ai][0][m][0], acc[ai][0][m][1]), s1 = sumsq8(acc[ai][1][m][0], acc[ai][1][m][1]);
                    s0 += __shfl_xor(s0, 16); s0 += __shfl_xor(s0, 32); s1 += __shfl_xor(s1, 16); s1 += __shfl_xor(s1, 32); mx0 = fmaxf(mx0, s0); mx1 = fmaxf(mx1, s1); }
#pragma unroll
            for (int o_ = 1; o_ < 16; o_ <<= 1) { mx0 = fmaxf(mx0, __shfl_xor(mx0, o_)); mx1 = fmaxf(mx1, __shfl_xor(mx1, o_)); }
            if (fr == 0 && fq == 0) { const int b = (u.pm * 256) / SEQ;
                atomicMax(KMAX + (b * 4 + (wc >> 1)) * 2 + (wc & 1), __float_as_uint(mx0)); atomicMax(KMAX + (b * 4 + 2 + (wc >> 1)) * 2 + (wc & 1), __float_as_uint(mx1)); }
        }
    }
};
struct EpiUp {
    static constexpr bool FUSED = false;
    bf16_t* KV; bf16_t* QD; const float* SS; const float* cosT; const float* sinT;
    __device__ __forceinline__ void operator()(const f32x4 (&acc)[2][2][4][2], const pg8::Unit& u, int wr, int wc, int fr, int fq) const {
        const int row0 = u.pm * 256 + wr * 64 + fr;
#pragma unroll
        for (int ai = 0; ai < 2; ++ai)
#pragma unroll
            for (int m = 0; m < 4; ++m) { const int row = row0 + ai * 128 + m * 16;
                const f32x4 sa = *(const f32x4*)(SS + (size_t)row * 12), sb = *(const f32x4*)(SS + (size_t)row * 12 + 4), sc = *(const f32x4*)(SS + (size_t)row * 12 + 8);
                if (u.pn < 2) {
                    const float rs = rsqrtf(((sc[0] + sc[1]) + (sc[2] + sc[3])) * (1.f / 128.f) + RMS_EPS);
#pragma unroll
                    for (int bj = 0; bj < 2; ++bj) *(u32x4*)(KV + (size_t)row * 512 + 256 * u.pn + 128 * bj + 32 * wc + 8 * fq) = pack8(acc[ai][bj][m][0] * rs, acc[ai][bj][m][1] * rs);
                } else {
                    const float rs = rsqrtf((((sa[0] + sa[1]) + (sa[2] + sa[3])) + ((sb[0] + sb[1]) + (sb[2] + sb[3]))) * (1.f / 384.f) + RMS_EPS);
#pragma unroll
                    for (int bj = 0; bj < 2; ++bj) { if (u.pn == 3 && bj == 1) continue;
                        const int c0 = 256 * (u.pn - 2) + 128 * bj + 32 * wc;
                        f32x4 v0 = acc[ai][bj][m][0] * rs, v1 = acc[ai][bj][m][1] * rs;
                        if ((c0 % 96) == 64) rope8(v0, v1, cosT + (size_t)row * 16, sinT + (size_t)row * 16, fq);
                        *(u32x4*)(QD + (size_t)row * 384 + c0 + 8 * fq) = pack8(v0, v1); }
                }
                asm volatile("" ::: "memory");
            }
    }
};
struct EpiY {
    static constexpr bool FUSED = false;
    bf16_t* Y; float* YSS;
    __device__ __forceinline__ void operator()(const f32x4 (&acc)[2][2][4][2], const pg8::Unit& u, int wr, int wc, int fr, int fq) const {
        const int row0 = u.pm * 256 + wr * 64 + fr, colb = u.pn * 256 + wc * 32 + 8 * fq;
#pragma unroll
        for (int ai = 0; ai < 2; ++ai)
#pragma unroll
            for (int m = 0; m < 4; ++m) { const int row = row0 + ai * 128 + m * 16;
                *(u32x4*)(Y + (size_t)row * DM + colb) = pack8(acc[ai][0][m][0], acc[ai][0][m][1]);
                *(u32x4*)(Y + (size_t)row * DM + colb + 128) = pack8(acc[ai][1][m][0], acc[ai][1][m][1]);
                float s = sumsq8(acc[ai][0][m][0], acc[ai][0][m][1]) + sumsq8(acc[ai][1][m][0], acc[ai][1][m][1]);
                s += __shfl_xor(s, 16); s += __shfl_xor(s, 32);
                if (fq == 0) YSS[(size_t)row * 16 + 4 * u.pn + wc] = s; }
    }
};
__device__ __forceinline__ float silu_mul(float g, float u) { return g * __builtin_amdgcn_rcpf(1.f + __builtin_amdgcn_exp2f(-g * LOG2E)) * u; }
struct EpiH {
    static constexpr bool FUSED = false;
    bf16_t* H;
    __device__ __forceinline__ void operator()(const f32x4 (&acc)[2][2][4][2], const pg8::Unit& u, int wr, int wc, int fr, int fq) const {
        const int row0 = u.pm * 256 + wr * 64 + fr, colb = u.pn * 128 + wc * 32 + 8 * fq;
#pragma unroll
        for (int ai = 0; ai < 2; ++ai)
#pragma unroll
            for (int m = 0; m < 4; ++m) { const int row = row0 + ai * 128 + m * 16; f32x4 h0, h1;
#pragma unroll
                for (int e = 0; e < 4; ++e) { h0[e] = silu_mul(acc[ai][0][m][0][e], acc[ai][1][m][0][e]); h1[e] = silu_mul(acc[ai][0][m][1][e], acc[ai][1][m][1][e]); }
                *(u32x4*)(H + (size_t)row * DFF + colb) = pack8(h0, h1); }
    }
};

constexpr int TAB_OFF = 131072 + 1024;
struct RowStat {
    unsigned* slot; unsigned* cnt;
    __device__ __forceinline__ void run(const float (&part)[8], const pg8::Unit& u, int wr, int wc, int fr, int fq, LAS unsigned char* lds, int wid, int lane, int tid_) const {
        int tid = tid_; asm volatile("" : "+v"(tid));
        LAS float* P = (LAS float*)(lds + TAB_OFF); LAS float* S = (LAS float*)(lds + TAB_OFF + 4096);
#pragma unroll
        for (int i = 0; i < 8; ++i) { float v = part[i]; v += __shfl_xor(v, 16); v += __shfl_xor(v, 32); if (fq == 0) P[((i >> 2) * 128 + wr * 64 + (i & 3) * 16 + fr) * 4 + wc] = v; }
        asm volatile("s_waitcnt lgkmcnt(0)" ::: "memory"); __builtin_amdgcn_s_barrier(); asm volatile("" ::: "memory");
        if (wid < 4) {
            const f32x4 p4 = *(const LAS f32x4*)(P + tid * 4);
            __hip_atomic_store(slot + ((size_t)(u.pm * 256 + tid)) * 4 + u.pn, __float_as_uint((p4[0] + p4[1]) + (p4[2] + p4[3])), __ATOMIC_RELAXED, __HIP_MEMORY_SCOPE_AGENT);
            asm volatile("s_waitcnt vmcnt(0)" ::: "memory");
            if (lane == 0) __hip_atomic_fetch_add(cnt + 64 * u.pm, 1u, __ATOMIC_RELAXED, __HIP_MEMORY_SCOPE_AGENT);
        }
        if (wid == 0) {
            unsigned spins = 0;
            while ((unsigned)__builtin_amdgcn_readfirstlane(__hip_atomic_load(cnt + 64 * u.pm, __ATOMIC_RELAXED, __HIP_MEMORY_SCOPE_AGENT)) < 16u) { __builtin_amdgcn_s_sleep(2); if (++spins > (1u << 20)) break; }
            __builtin_amdgcn_fence(__ATOMIC_ACQUIRE, "agent");
        }
        asm volatile("s_waitcnt vmcnt(0) lgkmcnt(0)" ::: "memory"); __builtin_amdgcn_s_barrier(); asm volatile("" ::: "memory");
        if (wid < 4) { const unsigned* sp = slot + ((size_t)(u.pm * 256 + tid)) * 4; float t = 0.f;
#pragma unroll
            for (int k = 0; k < 4; ++k) t += __uint_as_float(__hip_atomic_load(sp + k, __ATOMIC_RELAXED, __HIP_MEMORY_SCOPE_AGENT));
            S[tid] = t; }
        asm volatile("s_waitcnt lgkmcnt(0)" ::: "memory"); __builtin_amdgcn_s_barrier(); asm volatile("" ::: "memory");
    }
};
struct EpiFused {
    static constexpr bool FUSED = true;
    const float* xin; float* xout; bf16_t* XN; const float* gpost; const float* modg; int gate_chunk; const float* gpre; const float* modn; int sc_chunk, sh_chunk; RowStat stA, stC; int do_norm;
    __device__ __forceinline__ void fused(f32x4 (&acc)[2][2][4][2], const pg8::Unit& u, int wr, int wc, int fr, int fq, LAS unsigned char* lds, int wid, int lane, int tid) const {
        int frv = fr, fqv = fq; asm volatile("" : "+v"(frv), "+v"(fqv));
        const int b = (u.pm * 256) / SEQ, rloc0 = wr * 64 + frv, colb = u.pn * 256 + wc * 32 + 8 * fqv;
        const LAS float* S = (const LAS float*)(lds + TAB_OFF + 4096);
        float part[8];
#pragma unroll
        for (int i = 0; i < 8; ++i) part[i] = sumsq8(acc[i >> 2][0][i & 3][0], acc[i >> 2][0][i & 3][1]) + sumsq8(acc[i >> 2][1][i & 3][0], acc[i >> 2][1][i & 3][1]);
        stA.run(part, u, wr, wc, fr, fq, lds, wid, lane, tid);
        { f32x4 gg[2][2];
#pragma unroll
          for (int bj = 0; bj < 2; ++bj)
#pragma unroll
            for (int n = 0; n < 2; ++n) gg[bj][n] = *(const f32x4*)(modg + (size_t)b * 6144 + gate_chunk * 1024 + colb + 128 * bj + 4 * n) * *(const f32x4*)(gpost + colb + 128 * bj + 4 * n);
#pragma unroll
          for (int ai = 0; ai < 2; ++ai)
#pragma unroll
            for (int m = 0; m < 4; ++m) { const int rl = ai * 128 + rloc0 + m * 16; const float rs = rsqrtf(S[rl] * (1.f / DM) + RMS_EPS); const size_t off = (size_t)(u.pm * 256 + rl) * DM + colb;
#pragma unroll
                for (int bj = 0; bj < 2; ++bj)
#pragma unroll
                    for (int n = 0; n < 2; ++n) { const f32x4 xo = *(const f32x4*)(xin + off + 128 * bj + 4 * n); const f32x4 xn = xo + acc[ai][bj][m][n] * (gg[bj][n] * rs); acc[ai][bj][m][n] = xn; *(f32x4*)(xout + off + 128 * bj + 4 * n) = xn; }
                asm volatile("" ::: "memory"); } }
        if (!do_norm) return;
#pragma unroll
        for (int i = 0; i < 8; ++i) part[i] = sumsq8(acc[i >> 2][0][i & 3][0], acc[i >> 2][0][i & 3][1]) + sumsq8(acc[i >> 2][1][i & 3][0], acc[i >> 2][1][i & 3][1]);
        stC.run(part, u, wr, wc, fr, fq, lds, wid, lane, tid);
        { f32x4 gs[2][2], sh[2][2];
#pragma unroll
          for (int bj = 0; bj < 2; ++bj)
#pragma unroll
            for (int n = 0; n < 2; ++n) { const int c = colb + 128 * bj + 4 * n; gs[bj][n] = *(const f32x4*)(gpre + c) * (*(const f32x4*)(modn + (size_t)b * 6144 + sc_chunk * 1024 + c) + 1.f); sh[bj][n] = *(const f32x4*)(modn + (size_t)b * 6144 + sh_chunk * 1024 + c); }
#pragma unroll
          for (int ai = 0; ai < 2; ++ai)
#pragma unroll
            for (int m = 0; m < 4; ++m) { const int rl = ai * 128 + rloc0 + m * 16; const float rs = rsqrtf(S[rl] * (1.f / DM) + RMS_EPS); const size_t off = (size_t)(u.pm * 256 + rl) * DM + colb;
#pragma unroll
                for (int bj = 0; bj < 2; ++bj) *(u32x4*)(XN + off + 128 * bj) = pack8(acc[ai][bj][m][0] * (gs[bj][0] * rs) + sh[bj][0], acc[ai][bj][m][1] * (gs[bj][1] * rs) + sh[bj][1]);
            } }
    }
};

namespace att {
constexpr int STG = 21504, OFF_V = 12288, OFF_KPOS = 20480, NBUF = 6, WSF_OFF = NBUF * STG, LDS_BYTES = WSF_OFF + 8 * 256;
constexpr float THR = 8.f;
constexpr float SKIP_T = 24.f;
constexpr int MASK_OFF = 131072 + 512;
struct Unit {
    const bf16_t* Q; int qp; const bf16_t* K1; int k1p; const bf16_t* K2; int k2p; const bf16_t* V; int vp;
    const float* posf; int r, d, n, i0, kbase, ntiles, radius;
    float slope2, m_init, l_init;
    bf16_t* O; int op; float* lse; float lam, cscale; const float* gdiff;
    int hsplit; float slope2b, m_initb;
    const float* pmm; float kn0, kn1;
};
__device__ __forceinline__ float mx3(float a, float b, float c) { return fmaxf(fmaxf(a, b), c); }
__device__ __forceinline__ s16x4 vtr(const LAS unsigned char* p) { return __builtin_bit_cast(s16x4, __builtin_amdgcn_ds_read_tr16_b64_v4i16((LAS s16x4*)p)); }
__device__ __forceinline__ float xhalf(float v, bool sum) { auto rr = __builtin_amdgcn_permlane32_swap(__float_as_uint(v), __float_as_uint(v), false, false);
    const float a = __uint_as_float(rr[0]), b = __uint_as_float(rr[1]); return sum ? a + b : fmaxf(a, b); }
__device__ __forceinline__ void glds16(const void* gsrc, unsigned lds_dst) { unsigned keep;
    asm volatile("s_mov_b32 %0, m0\n\ts_mov_b32 m0, %2\n\ts_nop 0\n\tglobal_load_lds_dwordx4 %1, off\n\ts_mov_b32 m0, %0" : "=&s"(keep) : "v"(gsrc), "s"(lds_dst) : "memory"); }
__device__ __forceinline__ void glds4(const void* gsrc, unsigned lds_dst) { unsigned keep;
    asm volatile("s_mov_b32 %0, m0\n\ts_mov_b32 m0, %2\n\ts_nop 0\n\tglobal_load_lds_dword %1, off\n\ts_mov_b32 m0, %0" : "=&s"(keep) : "v"(gsrc), "s"(lds_dst) : "memory"); }
template <int MODE>
__device__ __forceinline__ void attn_unit(const Unit& u, LAS unsigned char* lds, const int tid) {
    constexpr int DQK = (MODE == 2) ? 96 : 64, NMAP = (MODE == 1) ? 2 : 1, ND0 = DQK / 16;
    const int lane = tid & 63, r32 = lane & 31, hi = lane >> 5, wid = __builtin_amdgcn_readfirstlane(tid >> 6);
    LAS float* wsf = (LAS float*)(lds + WSF_OFF) + wid * 64;
    const int wrow = (MODE == 0 && u.hsplit) ? (wid & 3) : wid, hh = (MODE == 0 && u.hsplit) ? (wid >> 2) : 0;
    const float slope2 = (MODE == 0 && hh) ? u.slope2b : u.slope2;
    const int qi = u.i0 + 32 * wrow + r32, qtok = u.r + u.d * qi;
    bf16x8 q[ND0];
#pragma unroll
    for (int d0 = 0; d0 < ND0; ++d0) q[d0] = *(const bf16x8*)(u.Q + (size_t)qtok * u.qp + 64 * hh + 16 * d0 + 8 * hi);
    float pq = (MODE != 2) ? u.posf[qtok] : 0.f;
#pragma unroll
    for (int d0 = 0; d0 < ND0; ++d0) asm volatile("" : "+v"(q[d0]));
    asm volatile("" : "+v"(pq));
    const unsigned lds0 = (unsigned)(uintptr_t)lds;
#define ATT_LOAD(j, buf) do { const unsigned st_ = (unsigned)__builtin_amdgcn_readfirstlane((int)(lds0 + (unsigned)(buf) * STG)); \
        { int idx = u.kbase + 64 * (j) + lane; idx = idx < 0 ? 0 : (idx > u.n - 1 ? u.n - 1 : idx); const size_t tok = (size_t)(u.r + u.d * idx); \
            glds16(u.K1 + tok * u.k1p + 8 * wid, st_ + wid * 1024); \
            if (MODE == 2 && wid < 4) glds16(u.K2 + tok * u.k2p + 8 * wid, st_ + (8 + wid) * 1024); \
            if (MODE != 2 && wid == 7) glds4(u.posf + tok, st_ + OFF_KPOS); } \
        { int idx = u.kbase + 64 * (j) + 16 * (wid & 3) + (lane >> 2); idx = idx < 0 ? 0 : (idx > u.n - 1 ? u.n - 1 : idx); const size_t tok = (size_t)(u.r + u.d * idx); \
            glds16(u.V + tok * u.vp + 32 * (wid >> 2) + 8 * (lane & 3), st_ + OFF_V + wid * 1024); } } while (0)
#define ATT_STORE(buf) do { } while (0)
#define ATT_SYNC() asm volatile("s_waitcnt vmcnt(0) lgkmcnt(0)\n\ts_barrier" ::: "memory")
    float m_run[NMAP], l_run[NMAP]; f32x16 o[NMAP][2];
#pragma unroll
    for (int mp = 0; mp < NMAP; ++mp) { m_run[mp] = MODE == 2 ? 0.f : ((MODE == 0 && hh) ? u.m_initb : u.m_init); l_run[mp] = hi == 0 ? u.l_init : 0.f; o[mp][0] = f32x16{}; o[mp][1] = f32x16{}; }
    int j_lo = 0, j_hi = u.ntiles - 1;
    if (MODE == 0) { j_lo = wrow >> 1; j_hi = (32 * wrow + 31 + 2 * u.radius) >> 6; }
    constexpr int NPASS = (MODE == 1) ? 2 : 1;
    constexpr bool STAG = (MODE != 1);
    const bool late = STAG && (wid >= 4);
    bf16x8 pa[4]; bool pend = false; int bprev = 0; bool first = true;
    f32x16 negm = f32x16{};
    if (MODE == 2) { float z_ = 0.f; asm volatile("" : "+v"(z_));
#pragma unroll
        for (int r = 0; r < 16; ++r) negm[r] = z_; }
#define ATT_PV(stp, oacc) do { unsigned vbo = (unsigned)(uintptr_t)((stp) + OFF_V + ((lane >> 4) & 1) * 32 + (lane & 3) * 8 + (4 * hi + ((lane & 15) >> 2)) * 64); asm volatile("" : "+v"(vbo)); \
        const LAS unsigned char* vbm = (const LAS unsigned char*)(uintptr_t)vbo; \
        _Pragma("unroll") for (int dblk = 0; dblk < 2; ++dblk) _Pragma("unroll") for (int s4 = 0; s4 < 4; ++s4) { \
            const s16x4 lo = vtr(vbm + dblk * 4096 + s4 * 1024), hh = vtr(vbm + dblk * 4096 + s4 * 1024 + 512); \
            const bf16x8 bv = {lo[0], lo[1], lo[2], lo[3], hh[0], hh[1], hh[2], hh[3]}; \
            (oacc)[dblk] = __builtin_amdgcn_mfma_f32_32x32x16_bf16(pa[s4], bv, (oacc)[dblk], 0, 0, 0); } } while (0)
#pragma unroll 1
    for (int pass = 0; pass < NPASS; ++pass) {
        unsigned long long bm, wm;
        if (MODE == 1) {
            const unsigned long long diag = 0xFull << (u.i0 >> 6);
            if (pass == 0) { bm = diag; wm = diag; }
            else {
                float qn0, qn1, pqmin = pq, pqmax = pq;
                { float s0 = 0.f, s1 = 0.f;
#pragma unroll
                  for (int e = 0; e < 8; ++e) { const float a0 = bf2f((bf16_t)q[0][e]), a1 = bf2f((bf16_t)q[1][e]), b0 = bf2f((bf16_t)q[ND0 - 2][e]), b1 = bf2f((bf16_t)q[ND0 - 1][e]); s0 += a0 * a0 + a1 * a1; s1 += b0 * b0 + b1 * b1; }
                  s0 = xhalf(s0, true); s1 = xhalf(s1, true);
#pragma unroll
                  for (int o_ = 1; o_ < 32; o_ <<= 1) { s0 = fmaxf(s0, __shfl_xor(s0, o_)); s1 = fmaxf(s1, __shfl_xor(s1, o_)); pqmin = fminf(pqmin, __shfl_xor(pqmin, o_)); pqmax = fmaxf(pqmax, __shfl_xor(pqmax, o_)); }
                  qn0 = sqrtf(s0); qn1 = sqrtf(s1); }
                float ml0 = m_run[0], ml1 = m_run[NMAP - 1];
#pragma unroll
                for (int o_ = 1; o_ < 32; o_ <<= 1) { ml0 = fminf(ml0, __shfl_xor(ml0, o_)); ml1 = fminf(ml1, __shfl_xor(ml1, o_)); }
                const float pmn = u.pmm[2 * lane], pmx = u.pmm[2 * lane + 1];
                const float pen = u.slope2 * fmaxf(0.f, fmaxf(pmn - pqmax, pqmin - pmx));
                const bool need = (qn0 * u.kn0 - pen >= ml0 - SKIP_T) || (qn1 * u.kn1 - pen >= ml1 - SKIP_T);
                wm = __ballot(need) & ~diag;
                LAS unsigned long long* mk = (LAS unsigned long long*)(lds + MASK_OFF);
                if (lane == 0) mk[wid] = wm;
                __syncthreads();
                unsigned long long un = 0ull;
#pragma unroll
                for (int w = 0; w < 8; ++w) un |= mk[w];
                bm = ((unsigned long long)(unsigned)__builtin_amdgcn_readfirstlane((int)(un >> 32)) << 32) | (unsigned)__builtin_amdgcn_readfirstlane((int)un);
            }
        } else {
            bm = u.ntiles >= 64 ? ~0ull : ((1ull << u.ntiles) - 1ull);
            wm = bm; if (MODE == 0) wm = (j_hi >= 63 ? ~0ull : ((1ull << (j_hi + 1)) - 1ull)) & ~((1ull << j_lo) - 1ull);
        }
        if (bm == 0ull) continue;
        const bool preload = (MODE == 0) && (u.ntiles <= NBUF);
        if (preload) {
#pragma unroll 1
            for (int t = 0; t < u.ntiles; ++t) { ATT_LOAD(t, t); asm volatile("" ::: "memory"); }
        }
        int j = __builtin_ctzll(bm); bm &= bm - 1ull; int buf = 0;
        if (!preload) { ATT_LOAD(j, 0); ATT_STORE(0); }
        ATT_SYNC();
        for (;;) {
        const bool more = bm != 0ull; int jn = 0; const int bnext = buf == NBUF - 1 ? 0 : buf + 1;
        if (more) { jn = __builtin_ctzll(bm); bm &= bm - 1ull; if (!preload) ATT_LOAD(jn, bnext); }
        if (STAG && late && pend) { ATT_PV(lds + bprev * STG, o[0]); pend = false; }
        if ((wm >> j) & 1ull) {
            const LAS unsigned char* st = lds + buf * STG;
            const LAS unsigned char* kb = st + hi * 1024 + r32 * 16;
#pragma unroll
            for (int mp = 0; mp < NMAP; ++mp) {
                f32x16 p0, p1;
                constexpr int DPM = ND0 / NMAP;
#pragma unroll
                for (int dd = 0; dd < DPM; ++dd) { const int d0 = mp * DPM + dd;
                    const bf16x8 a0 = *(const LAS bf16x8*)(kb + d0 * 2048), a1 = *(const LAS bf16x8*)(kb + d0 * 2048 + 512);
                    if (dd == 0) { const f32x16 c0 = (MODE == 2) ? negm : f32x16{}; p0 = __builtin_amdgcn_mfma_f32_32x32x16_bf16(a0, q[d0], c0, 0, 0, 0); p1 = __builtin_amdgcn_mfma_f32_32x32x16_bf16(a1, q[d0], c0, 0, 0, 0); }
                    else { p0 = __builtin_amdgcn_mfma_f32_32x32x16_bf16(a0, q[d0], p0, 0, 0, 0); p1 = __builtin_amdgcn_mfma_f32_32x32x16_bf16(a1, q[d0], p1, 0, 0, 0); } }
                if (MODE != 2) {
                    unsigned sto = (unsigned)(uintptr_t)st; asm volatile("" : "+v"(sto)); const LAS unsigned char* stm = (const LAS unsigned char*)(uintptr_t)sto;
#pragma unroll
                    for (int g = 0; g < 4; ++g) {
                        const f32x4 ka = *(const LAS f32x4*)(stm + OFF_KPOS + 4 * (8 * g + 4 * hi)), kb4 = *(const LAS f32x4*)(stm + OFF_KPOS + 4 * (32 + 8 * g + 4 * hi));
#pragma unroll
                        for (int e = 0; e < 4; ++e) { const int r = 4 * g + e;
                            float s0 = p0[r] - slope2 * fabsf(pq - ka[e]), s1 = p1[r] - slope2 * fabsf(pq - kb4[e]);
                            if (MODE == 0) { const int k0 = u.kbase + 64 * j + 8 * g + 4 * hi + e, k1 = k0 + 32;
                                if ((unsigned)(k0 - qi + u.radius) > (unsigned)(2 * u.radius) || (unsigned)k0 >= (unsigned)u.n) s0 = -1e30f;
                                if ((unsigned)(k1 - qi + u.radius) > (unsigned)(2 * u.radius) || (unsigned)k1 >= (unsigned)u.n) s1 = -1e30f; }
                            p0[r] = s0; p1[r] = s1; }
                    }
                }
                float ra = mx3(p0[0], p0[1], p1[0]), rb = mx3(p0[2], p0[3], p1[1]); ra = mx3(ra, p1[2], p1[3]);
#pragma unroll
                for (int r = 4; r < 16; r += 4) { ra = mx3(ra, p0[r], p0[r + 1]); rb = mx3(rb, p0[r + 2], p0[r + 3]); ra = mx3(ra, p1[r], p1[r + 1]); rb = mx3(rb, p1[r + 2], p1[r + 3]); }
                const float rm = xhalf(fmaxf(ra, rb), false);
                float mr;
                if (MODE == 2) {
                    if (first || __any(rm > THR)) {
                        const float dl = first ? rm : fmaxf(rm, 0.f); m_run[mp] += dl;
#pragma unroll
                        for (int r = 0; r < 16; ++r) { p0[r] -= dl; p1[r] -= dl; negm[r] = -m_run[mp]; }
                        if (!first) { const float f = __builtin_amdgcn_exp2f(-dl); l_run[mp] *= f; if (hi == 0) wsf[r32] = f;
                            __builtin_amdgcn_wave_barrier();
#pragma unroll
                            for (int g = 0; g < 4; ++g) { const f32x4 f4 = *(const LAS f32x4*)(wsf + 8 * g + 4 * hi);
#pragma unroll
                                for (int e = 0; e < 4; ++e) { o[mp][0][4 * g + e] *= f4[e]; o[mp][1][4 * g + e] *= f4[e]; } }
                            __builtin_amdgcn_wave_barrier(); }
                        first = false;
                    }
                    mr = 0.f;
                } else {
                    if (__any(rm > m_run[mp] + THR)) {
                        const float mn = fmaxf(m_run[mp], rm); const float f = __builtin_amdgcn_exp2f(m_run[mp] - mn); l_run[mp] *= f; m_run[mp] = mn; if (hi == 0) wsf[r32] = f;
                        __builtin_amdgcn_wave_barrier();
#pragma unroll
                        for (int g = 0; g < 4; ++g) { const f32x4 f4 = *(const LAS f32x4*)(wsf + 8 * g + 4 * hi);
#pragma unroll
                            for (int e = 0; e < 4; ++e) { o[mp][0][4 * g + e] *= f4[e]; o[mp][1][4 * g + e] *= f4[e]; } }
                        __builtin_amdgcn_wave_barrier();
                    }
                    mr = m_run[mp];
                }
                float s = 0.f;
#pragma unroll
                for (int r = 0; r < 16; ++r) { p0[r] = __builtin_amdgcn_exp2f(MODE == 2 ? p0[r] : p0[r] - mr); p1[r] = __builtin_amdgcn_exp2f(MODE == 2 ? p1[r] : p1[r] - mr); s += p0[r] + p1[r]; }
                l_run[mp] += s;
#pragma unroll
                for (int s2 = 0; s2 < 2; ++s2) {
                    u32x4 w; w.x = cvtpk(p0[8 * s2], p0[8 * s2 + 1]); w.y = cvtpk(p0[8 * s2 + 2], p0[8 * s2 + 3]); w.z = cvtpk(p0[8 * s2 + 4], p0[8 * s2 + 5]); w.w = cvtpk(p0[8 * s2 + 6], p0[8 * s2 + 7]); pa[s2] = __builtin_bit_cast(bf16x8, w);
                    u32x4 x; x.x = cvtpk(p1[8 * s2], p1[8 * s2 + 1]); x.y = cvtpk(p1[8 * s2 + 2], p1[8 * s2 + 3]); x.z = cvtpk(p1[8 * s2 + 4], p1[8 * s2 + 5]); x.w = cvtpk(p1[8 * s2 + 6], p1[8 * s2 + 7]); pa[2 + s2] = __builtin_bit_cast(bf16x8, x); }
                if (STAG && late) { pend = true; bprev = buf; }
                else { ATT_PV(st, o[mp]); }
                if (NMAP > 1) __builtin_amdgcn_sched_barrier(0);
            }
        }
        if (!more) break;
        if (!preload) { ATT_STORE(bnext); ATT_SYNC(); }
        j = jn; buf = bnext;
        }
        if (STAG && late && pend) { ATT_PV(lds + bprev * STG, o[0]); pend = false; }
        ATT_SYNC();
    }
#undef ATT_PV
#undef ATT_LOAD
#undef ATT_STORE
#undef ATT_SYNC
    int r32v = r32, hiv = hi, widv = wrow, hhv = hh; asm volatile("" : "+v"(r32v), "+v"(hiv), "+s"(widv), "+s"(hhv));
    float lt[NMAP];
#pragma unroll
    for (int mp = 0; mp < NMAP; ++mp) lt[mp] = xhalf(l_run[mp], true);
    if (MODE == 0 && u.lse && hiv == 0) u.lse[(size_t)(u.r + u.d * (u.i0 + 32 * widv + r32v)) * 4] = m_run[0] + __builtin_amdgcn_logf(lt[0]);
    if (hiv == 0) { wsf[r32v] = 1.f / lt[0]; if (MODE == 1) wsf[32 + r32v] = u.lam / lt[NMAP - 1]; }
    __builtin_amdgcn_wave_barrier();
    float val[2][16];
#pragma unroll
    for (int g = 0; g < 4; ++g) { const f32x4 f4 = *(const LAS f32x4*)(wsf + 8 * g + 4 * hiv); f32x4 h4 = {0.f, 0.f, 0.f, 0.f}; if (MODE == 1) h4 = *(const LAS f32x4*)(wsf + 32 + 8 * g + 4 * hiv);
#pragma unroll
        for (int e = 0; e < 4; ++e) { const int r = 4 * g + e;
#pragma unroll
            for (int dblk = 0; dblk < 2; ++dblk) { float v = o[0][dblk][r] * f4[e]; if (MODE == 1) v -= o[NMAP - 1][dblk][r] * h4[e]; val[dblk][r] = v; } } }
    __builtin_amdgcn_wave_barrier();
    if (MODE == 1) {
        const float g0 = u.gdiff[r32v], g1 = u.gdiff[32 + r32v];
#pragma unroll
        for (int r = 0; r < 16; ++r) { float ss = val[0][r] * val[0][r] + val[1][r] * val[1][r];
            ss += __shfl_xor(ss, 1); ss += __shfl_xor(ss, 2); ss += __shfl_xor(ss, 4); ss += __shfl_xor(ss, 8); ss += __shfl_xor(ss, 16);
            const float rs = rsqrtf(ss * (1.f / 64.f) + RMS_EPS) * u.cscale; val[0][r] *= rs * g0; val[1][r] *= rs * g1; }
    }
#pragma unroll
    for (int r = 0; r < 16; ++r) { const int qr = u.i0 + 32 * widv + (r & 3) + 8 * (r >> 2) + 4 * hiv; const size_t tok = (size_t)(u.r + u.d * qr);
        bf16_t* op_ = u.O + tok * u.op + 64 * hhv + r32v; op_[0] = f2bf(val[0][r]); op_[32] = f2bf(val[1][r]); }
}
}
#include <hip/hip_cooperative_groups.h>
namespace cg = cooperative_groups;
constexpr int NTHREADS = 512, NWAVES = 8;
constexpr int LDS_TOTAL = 131072 + 1024 + 4096 + 1024 + 64;
constexpr int WCONV_SPLIT = 0;
constexpr int KRSPLIT = 1;
constexpr int PJ_DIV = 4;
constexpr int XQUEUE = 1;
constexpr int FUSE_E = 1;
constexpr int NPH = 2 + 8 * DEPTH;
#ifndef MK_EN
#define MK_EN 0xFFFF
#endif
#define EN(b) ((MK_EN >> (b)) & 1)
struct MKArgs { const float* in[23]; float* out; unsigned char* ws; int ph_lo, ph_hi, xmask, ymask; };

#define GAS __attribute__((address_space(1)))
constexpr int CW_KMAX = 8192;
constexpr int CW_BAR = 4096;
constexpr size_t CTL_ZERO_BYTES = 65536 + 8 * 32768;
constexpr int CW_QUEUE = 12288;
constexpr int CW_CNT = 16384;
constexpr int MISC_OFF = 131072;
#define XB_TMO      128
#define XB_XCNT(j)  (256  + 64 * (j))
#define XB_XSUB(j)  (1280 + 64 * (j))
#define XB_XGEN(j)  (2304 + 64 * (j))
#define XB_TOP      3328
#define XB_TOPGEN   3392
#define XCD_BAR_WORDS 3456
#define XB_SPIN_CAP (1u << 18)

__device__ __forceinline__ unsigned xb_ld(unsigned* p)              { return __hip_atomic_load(p, __ATOMIC_RELAXED, __HIP_MEMORY_SCOPE_AGENT); }
__device__ __forceinline__ unsigned xb_add(unsigned* p, unsigned v) { return __hip_atomic_fetch_add(p, v, __ATOMIC_RELAXED, __HIP_MEMORY_SCOPE_AGENT); }
__device__ __forceinline__ unsigned xb_xcc_id() { return (unsigned)__builtin_amdgcn_s_getreg((3 << 11) | 20) & 0xFu; }
#define XB_SPIN(cond, bar) do { unsigned _sp = 0; while (cond) { __builtin_amdgcn_s_sleep(1); \
    if ((++_sp & 255u) == 0u) { if (xb_ld(&(bar)[XB_TMO])) break; if (_sp > XB_SPIN_CAP) { atomicAdd(&(bar)[XB_TMO], 1u); break; } } } } while (0)

struct XcdBarrier {
    unsigned* bar; unsigned x;
    volatile LAS unsigned* st;
};

__device__ __forceinline__ XcdBarrier xcd_barrier_post(unsigned* bar, volatile LAS unsigned* st) {
    XcdBarrier b; b.bar = bar; b.x = xb_xcc_id(); b.st = st;
    if (threadIdx.x == 0) st[3] = xb_add(&bar[XB_XCNT(b.x)], 1u);
    return b;
}
__device__ __forceinline__ void xcd_barrier_complete(unsigned* bar, unsigned x, unsigned& nloc, unsigned& nx, unsigned& uni) {
    const unsigned G = gridDim.x * gridDim.y * gridDim.z;
    unsigned sum, cnt, mine, even, sp = 0u;
    for (;;) {
        sum = 0u; cnt = 0u; mine = 0u; even = 1u;
#pragma unroll
        for (unsigned j = 0; j < 16; ++j) { const unsigned c = xb_ld(&bar[XB_XCNT(j)]); sum += c; cnt += (c > 0u) ? 1u : 0u; mine = (j == x) ? c : mine; even &= (c == (j < 8u ? G / 8u : 0u)) ? 1u : 0u; }
        if (sum == G) break;
        __builtin_amdgcn_s_sleep(1);
        if ((++sp & 255u) == 0u) { if (xb_ld(&bar[XB_TMO])) break; if (sp > XB_SPIN_CAP) { atomicAdd(&bar[XB_TMO], 1u); break; } }
    }
    nloc = mine > 0u ? mine : 1u; nx = cnt > 0u ? cnt : 1u;
    uni = (sum == G && (G & 7u) == 0u && even) ? 1u : 0u;
}

__device__ __forceinline__ void xcd_barrier(const XcdBarrier& b, const int tid_) {
    asm volatile("s_waitcnt vmcnt(0)" ::: "memory");
    __syncthreads();
    if (tid_ == 0) {
        unsigned* bar = b.bar;
        __builtin_amdgcn_s_waitcnt(0);
        unsigned nloc = b.st[0], nx = b.st[1];
        if (nloc == 0u) { unsigned uni; xcd_barrier_complete(bar, b.x, nloc, nx, uni); b.st[0] = nloc; b.st[1] = nx; b.st[2] = uni; }
        const unsigned old = xb_add(&bar[XB_XSUB(b.x)], 1u);
        const unsigned gen = old / nloc;
        if (old + 1u == (gen + 1u) * nloc) {
            __builtin_amdgcn_fence(__ATOMIC_RELEASE, "agent");
            asm volatile("s_waitcnt vmcnt(0)" ::: "memory");
            const unsigned og = xb_add(&bar[XB_TOP], 1u);
            const unsigned tg = og / nx;
            if (og + 1u == (tg + 1u) * nx) xb_add(&bar[XB_TOPGEN], 1u);
            else XB_SPIN(xb_ld(&bar[XB_TOPGEN]) == tg, bar);
            __builtin_amdgcn_fence(__ATOMIC_ACQUIRE, "agent");
            xb_add(&bar[XB_XGEN(b.x)], 1u);
            asm volatile("s_waitcnt vmcnt(0)" ::: "memory");
        } else {
            XB_SPIN(xb_ld(&bar[XB_XGEN(b.x)]) == gen, bar);
            __builtin_amdgcn_fence(__ATOMIC_ACQUIRE, "agent");
            asm volatile("s_waitcnt vmcnt(0)" ::: "memory");
        }
    }
    __syncthreads();
}

constexpr int CW_LBAR = 9216;
__device__ __forceinline__ void xcd_local_barrier(const XcdBarrier& b, unsigned* ctl, const int tid_) {
    asm volatile("s_waitcnt vmcnt(0)" ::: "memory");
    __syncthreads();
    if (tid_ == 0) {
        __builtin_amdgcn_s_waitcnt(0);
        const unsigned nloc = b.st[0];
        unsigned* sub = ctl + CW_LBAR + 64 * b.x; unsigned* gen_ = ctl + CW_LBAR + 1024 + 64 * b.x;
        const unsigned old = xb_add(sub, 1u), gen = old / nloc;
        if (old + 1u == (gen + 1u) * nloc) xb_add(gen_, 1u);
        else XB_SPIN(xb_ld(gen_) == gen, b.bar);
        __builtin_amdgcn_fence(__ATOMIC_ACQUIRE, "agent");
        asm volatile("s_waitcnt vmcnt(0)" ::: "memory");
    }
    __syncthreads();
}
__device__ __forceinline__ float wval(const MKArgs& a, int kind, int l, int k, int n) {
    if (kind == 0) { if (n >= IN_W) return 0.f; float v = a.in[7][((size_t)l * 1024 + k) * IN_W + n];
        if (n < 256 || (n >= ZB_Q && n < ZB_Q + 256)) v *= 0.125f * LOG2E; else if (n >= ZC_Q && n < ZC_Q + 256) v *= 0.17677669529663687f * LOG2E; return v; }
    if (kind == 1) { if (n < 512) return k >= 384 ? a.in[15][l * 128 + (k - 384)] * a.in[17][((size_t)l * 128 + (k - 384)) * 512 + n] : 0.f;
        if (n < 896) return k < 384 ? a.in[14][l * 384 + k] * a.in[16][((size_t)l * 384 + k) * 384 + (n - 512)] * (0.10206207261596575f * LOG2E) : 0.f;
        return 0.f; }
    if (kind == 2) return a.in[18][((size_t)l * 1024 + k) * 1024 + n];
    if (kind == 3) { const int pn = n >> 8, wi = n & 255; const int src = wi < 128 ? pn * 128 + wi : DFF + pn * 128 + (wi - 128); return a.in[21][((size_t)l * 1024 + k) * NGU + src]; }
    return a.in[22][((size_t)l * DFF + k) * 1024 + n];
}
__device__ __forceinline__ void transpose_item(const MKArgs& a, int kind, int l, bf16_t* dst, int K, int k0, int n0, LAS float* scr, int lane) {
#pragma unroll
    for (int i = 0; i < 32; ++i) { const int kk = 2 * i + (lane >> 5); scr[kk * 33 + (lane & 31)] = wval(a, kind, l, k0 + kk, n0 + (lane & 31)); }
    asm volatile("s_waitcnt lgkmcnt(0)" ::: "memory");
    const int c = lane & 7;
#pragma unroll
    for (int j = 0; j < 4; ++j) { const int n = (lane >> 3) + 8 * j; const LAS float* s = scr + (8 * c) * 33 + n;
        u32x4 o; o.x = cvtpk(s[0 * 33], s[1 * 33]); o.y = cvtpk(s[2 * 33], s[3 * 33]); o.z = cvtpk(s[4 * 33], s[5 * 33]); o.w = cvtpk(s[6 * 33], s[7 * 33]);
        *(u32x4*)(dst + (size_t)(n0 + n) * K + k0 + 8 * c) = o; }
    asm volatile("s_waitcnt lgkmcnt(0)" ::: "memory");
}
__device__ __forceinline__ void ph_prologue(const MKArgs& a, LAS unsigned char* lds, int bid, int G, const int tid) {
    const int lane = tid & 63, wid = __builtin_amdgcn_readfirstlane(tid >> 6); (void)lane; (void)wid;
    float* MOD = (float*)(a.ws + WS_MOD);
    for (int it = bid; it < DEPTH * 96; it += G) {
        LAS float* sc_ = (LAS float*)lds;
        LAS float* red = (LAS float*)(lds + 32768);
        const int l = it / 96, cb = it % 96, cl = tid & 63, col = cb * 64 + cl, ks = tid >> 6;
        for (int i = tid; i < 8192; i += NTHREADS) { const int b = i >> 10, k = i & 1023; const float cv = a.in[1][i]; sc_[k * 8 + b] = cv / (1.f + expf(-cv)); }
        __syncthreads();
        float acc[8];
#pragma unroll
        for (int b = 0; b < 8; ++b) acc[b] = 0.f;
        const float* w = a.in[3] + (size_t)l * 1024 * 6144;
#pragma unroll 4
        for (int k = ks * 128; k < ks * 128 + 128; ++k) { const float wv = w[(size_t)k * 6144 + col];
            const f32x4 s0 = *(const LAS f32x4*)(sc_ + k * 8), s1 = *(const LAS f32x4*)(sc_ + k * 8 + 4);
#pragma unroll
            for (int b = 0; b < 4; ++b) { acc[b] += s0[b] * wv; acc[4 + b] += s1[b] * wv; } }
#pragma unroll
        for (int b = 0; b < 8; ++b) red[(ks * 8 + b) * 64 + cl] = acc[b];
        __syncthreads();
        { const int b = tid >> 6; float s = a.in[4][l * 6144 + col];
#pragma unroll
          for (int k2 = 0; k2 < 8; ++k2) s += red[(k2 * 8 + b) * 64 + cl];
          MOD[((size_t)l * 8 + b) * 6144 + col] = s; }
        __syncthreads();
    }
    { float* cosT = (float*)(a.ws + WS_COS); float* sinT = (float*)(a.ws + WS_SIN); const int* pos = (const int*)a.in[2];
      for (int idx = bid * NTHREADS + tid; idx < M * 16; idx += G * NTHREADS) { const int m = idx >> 4, i = idx & 15;
          const float inv = exp2f(-(float)i * (13.287712379549449f / 16.0f)); const float pf = (float)pos[m], ang = pf * inv; cosT[idx] = cosf(ang); sinT[idx] = sinf(ang);
          if (i == 0) ((float*)(a.ws + WS_POSF))[m] = pf; } }
    { float* PMM = (float*)(a.ws + WS_PMM); const int* pos = (const int*)a.in[2];
      for (int t = bid * NTHREADS + tid; t < BATCH * 64; t += G * NTHREADS) { int mn = pos[t * 64], mx = mn; for (int i = 1; i < 64; ++i) { const int p = pos[t * 64 + i]; mn = p < mn ? p : mn; mx = p > mx ? p : mx; } PMM[2 * t] = (float)mn; PMM[2 * t + 1] = (float)mx; } }
}
__device__ __forceinline__ void ph_wconv(const MKArgs& a, LAS unsigned char* lds, int bid, int G, const int tid, const int l0, const int l1) {
    const int lane = tid & 63, wid = __builtin_amdgcn_readfirstlane(tid >> 6);
    LAS float* scr = (LAS float*)(lds + wid * 8448);
    constexpr int I0 = 16 * 88, I1 = 8 * 32, I2 = 16 * 32, I3 = 16 * 176, I4 = 44 * 32, IL = I0 + I1 + I2 + I3 + I4;
    for (int it = l0 * IL + bid * NWAVES + wid; it < l1 * IL; it += G * NWAVES) {
        const int l = it / IL; int r = it % IL; bf16_t* W = (bf16_t*)(a.ws + WS_W + (size_t)l * W_LAYER);
        if (r < I0) { transpose_item(a, 0, l, W + W_IN / 2, 1024, 64 * (r / 88), 32 * (r % 88), scr, lane); continue; } r -= I0;
        if (r < I1) { transpose_item(a, 1, l, W + W_UP / 2, KUP, 64 * (r / 32), 32 * (r % 32), scr, lane); continue; } r -= I1;
        if (r < I2) { transpose_item(a, 2, l, W + W_OUT / 2, 1024, 64 * (r / 32), 32 * (r % 32), scr, lane); continue; } r -= I2;
        if (r < I3) { transpose_item(a, 3, l, W + W_GU / 2, 1024, 64 * (r / 176), 32 * (r % 176), scr, lane); continue; } r -= I3;
        transpose_item(a, 4, l, W + W_DN / 2, DFF, 64 * (r / 32), 32 * (r % 32), scr, lane);
    }
}
__device__ __forceinline__ void ph_elem(const ElemArgs& a, int gw, int ngw, int lane) {
    for (int m = gw; m < M; m += ngw) {
        const int b = m / SEQ; const float* modb = a.modg + (size_t)b * 6144; const float* modnb = a.modn + (size_t)b * 6144;
        f32x4 v[4];
#pragma unroll
        for (int j = 0; j < 4; ++j) v[j] = *(const f32x4*)(a.xin + (size_t)m * DM + 256 * j + 4 * lane);
        if (a.do_res) {
            const f32x4 q0 = *(const f32x4*)(a.YSS + (size_t)m * 16), q1 = *(const f32x4*)(a.YSS + (size_t)m * 16 + 4), q2 = *(const f32x4*)(a.YSS + (size_t)m * 16 + 8), q3 = *(const f32x4*)(a.YSS + (size_t)m * 16 + 12);
            const float ss = (((q0[0] + q0[1]) + (q0[2] + q0[3])) + ((q1[0] + q1[1]) + (q1[2] + q1[3]))) + (((q2[0] + q2[1]) + (q2[2] + q2[3])) + ((q3[0] + q3[1]) + (q3[2] + q3[3])));
            const float rs = rsqrtf(ss * (1.f / DM) + RMS_EPS);
#pragma unroll
            for (int j = 0; j < 4; ++j) { const int c0 = 256 * j + 4 * lane;
                const uint2 yy = *(const uint2*)(a.Y + (size_t)m * DM + c0);
                const float y0 = __uint_as_float(yy.x << 16), y1 = __uint_as_float(yy.x & 0xffff0000u), y2 = __uint_as_float(yy.y << 16), y3 = __uint_as_float(yy.y & 0xffff0000u);
                const f32x4 gp = *(const f32x4*)(a.gpost + c0), gt = *(const f32x4*)(modb + a.gate_chunk * 1024 + c0);
                v[j][0] += gt[0] * (y0 * rs * gp[0]); v[j][1] += gt[1] * (y1 * rs * gp[1]); v[j][2] += gt[2] * (y2 * rs * gp[2]); v[j][3] += gt[3] * (y3 * rs * gp[3]); }
#pragma unroll
            for (int j = 0; j < 4; ++j) *(f32x4*)(a.xout + (size_t)m * DM + 256 * j + 4 * lane) = v[j];
        }
        if (a.do_norm) {
            float s = 0.f;
#pragma unroll
            for (int j = 0; j < 4; ++j) s += (v[j][0] * v[j][0] + v[j][1] * v[j][1]) + (v[j][2] * v[j][2] + v[j][3] * v[j][3]);
            const float rs = rsqrtf(wave_sum(s) * (1.f / DM) + RMS_EPS);
#pragma unroll
            for (int j = 0; j < 4; ++j) { const int c0 = 256 * j + 4 * lane;
                const f32x4 g = *(const f32x4*)(a.gpre + c0), sc = *(const f32x4*)(modnb + a.sc_chunk * 1024 + c0), sh = *(const f32x4*)(modnb + a.sh_chunk * 1024 + c0);
                float o[4];
#pragma unroll
                for (int e = 0; e < 4; ++e) o[e] = v[j][e] * rs * g[e] * (1.f + sc[e]) + sh[e];
                uint2 w; w.x = cvtpk(o[0], o[1]); w.y = cvtpk(o[2], o[3]);
                *(uint2*)(a.XN + (size_t)m * DM + c0) = w; }
        }
    }
}
__device__ __forceinline__ void ph_elem0(const ElemArgs& a, int gw, int ngw, int lane) {
    f32x4 v[4], v1[4], v2[4];
#pragma unroll
    for (int j = 0; j < 4; ++j) { v[j] = (f32x4){0.f, 0.f, 0.f, 0.f}; v1[j] = v[j]; v2[j] = v[j]; }
    if (gw < M) {
#pragma unroll
        for (int j = 0; j < 4; ++j) v[j] = *(const f32x4*)(a.xin + (size_t)gw * DM + 256 * j + 4 * lane); }
    if (gw + ngw < M) {
#pragma unroll
        for (int j = 0; j < 4; ++j) v1[j] = *(const f32x4*)(a.xin + (size_t)(gw + ngw) * DM + 256 * j + 4 * lane); }
#pragma unroll 1
    for (int m = gw; m < M; m += ngw) {
        const int m2 = m + 2 * ngw;
        if (m2 < M) {
#pragma unroll
            for (int j = 0; j < 4; ++j) v2[j] = *(const f32x4*)(a.xin + (size_t)m2 * DM + 256 * j + 4 * lane); }
        const int b = m / SEQ; const float* modnb = a.modn + (size_t)b * 6144;
        float s = 0.f;
#pragma unroll
        for (int j = 0; j < 4; ++j) s += (v[j][0] * v[j][0] + v[j][1] * v[j][1]) + (v[j][2] * v[j][2] + v[j][3] * v[j][3]);
        const float rs = rsqrtf(wave_sum(s) * (1.f / DM) + RMS_EPS);
#pragma unroll
        for (int j = 0; j < 4; ++j) { const int c0 = 256 * j + 4 * lane;
            const f32x4 g = *(const f32x4*)(a.gpre + c0), sc = *(const f32x4*)(modnb + a.sc_chunk * 1024 + c0), sh = *(const f32x4*)(modnb + a.sh_chunk * 1024 + c0);
            float o[4];
#pragma unroll
            for (int e = 0; e < 4; ++e) o[e] = v[j][e] * rs * g[e] * (1.f + sc[e]) + sh[e];
            uint2 w; w.x = cvtpk(o[0], o[1]); w.y = cvtpk(o[2], o[3]);
            *(uint2*)(a.XN + (size_t)m * DM + c0) = w; }
#pragma unroll
        for (int j = 0; j < 4; ++j) { v[j] = v1[j]; v1[j] = v2[j]; }
    }
}
__device__ __forceinline__ void unit_common(att::Unit& u, const MKArgs& a, int b) { u.posf = (const float*)(a.ws + WS_POSF) + (size_t)b * SEQ; u.K2 = nullptr; u.k2p = 0; u.lse = nullptr; u.lam = 0.f; u.cscale = 1.f; u.gdiff = nullptr; u.pmm = nullptr; u.kn0 = 0.f; u.kn1 = 0.f; u.hsplit = 0; u.slope2b = 0.f; u.m_initb = 0.f; u.r = 0; u.d = 1; u.n = SEQ; u.radius = 0; }
__device__ __forceinline__ void run_unit_a(const MKArgs& a, LAS unsigned char* lds, int br, int ua, const int tid) {
    const bf16_t* Z = (const bf16_t*)(a.ws + WS_ZH); bf16_t* OA = (bf16_t*)(a.ws + WS_Y); float* LSE = (float*)(a.ws + WS_LSE);
    const int bh = ua >> 4, sub = ua & 15, b = bh >> 2, h = bh & 3, d = br == 0 ? 1 : (br == 1 ? 4 : 16);
    att::Unit u; unit_common(u, a, b);
    u.d = d; u.n = SEQ / d; u.r = br == 0 ? 0 : (br == 1 ? (sub >> 2) : sub); const int qblk = br == 0 ? sub : (br == 1 ? (sub & 3) : 0);
    u.i0 = 256 * qblk; u.radius = 64; u.kbase = u.i0 - 64; u.ntiles = 6;
    const bf16_t* Zb = Z + (size_t)b * SEQ * NZ;
    u.Q = Zb + ZA_Q + 64 * h; u.qp = NZ; u.K1 = Zb + ZA_K + 64 * h; u.k1p = NZ; u.V = Zb + ZA_V + 64 * h; u.vp = NZ;
    u.slope2 = alibi_slope(9 + h) * LOG2E; u.m_init = -1e20f; u.l_init = 0.f;
    u.O = OA + ((size_t)br * M + (size_t)b * SEQ) * 256 + 64 * h; u.op = 256; u.lse = LSE + ((size_t)br * M + (size_t)b * SEQ) * 4 + h;
    att::attn_unit<0>(u, lds, tid);
}
__device__ __forceinline__ void run_unit_b(const MKArgs& a, LAS unsigned char* lds, int l, int ub, const int tid) {
    const bf16_t* Z = (const bf16_t*)(a.ws + WS_ZH); bf16_t* MIX = (bf16_t*)(a.ws + WS_MIX);
    const int bg = ub >> 5, qblk = ub & 31, b = bg >> 1, g = bg & 1, h = 2 * g;
    att::Unit u; unit_common(u, a, b);
    u.i0 = 128 * qblk; u.radius = 128; u.kbase = u.i0 - 128; u.ntiles = 6; u.hsplit = 1;
    const bf16_t* Zb = Z + (size_t)b * SEQ * NZ;
    u.Q = Zb + ZB_Q + 64 * h; u.qp = NZ; u.K1 = Zb + ZB_K + 64 * g; u.k1p = NZ; u.V = Zb + ZB_V + 64 * g; u.vp = NZ;
    u.slope2 = alibi_slope(1 + h) * LOG2E; u.m_init = a.in[8][l * 4 + h] * LOG2E; u.l_init = 1.f;
    u.slope2b = alibi_slope(2 + h) * LOG2E; u.m_initb = a.in[8][l * 4 + h + 1] * LOG2E;
    u.O = MIX + (size_t)b * SEQ * DM + 256 + 64 * h; u.op = DM;
    att::attn_unit<0>(u, lds, tid);
}
__device__ __forceinline__ void run_unit_c(const MKArgs& a, LAS unsigned char* lds, int l, int uc, const int tid) {
    const bf16_t* Z = (const bf16_t*)(a.ws + WS_ZH); bf16_t* MIX = (bf16_t*)(a.ws + WS_MIX);
    const int bh = uc >> 4, qblk = uc & 15, b = bh >> 2, h = bh & 3;
    att::Unit u; unit_common(u, a, b);
    u.i0 = 256 * qblk; u.kbase = 0; u.ntiles = SEQ / 64;
    const bf16_t* Zb = Z + (size_t)b * SEQ * NZ;
    u.Q = Zb + ZC_Q + 64 * h; u.qp = NZ; u.K1 = Zb + ZC_K + 64 * h; u.k1p = NZ; u.V = Zb + ZC_V + 64 * h; u.vp = NZ;
    u.slope2 = alibi_slope(5 + h) * LOG2E; u.m_init = -1e20f; u.l_init = 0.f;
    const int li_ = tid & 31;
    const float d1 = wave_sum(a.in[9][l * 32 + li_] * a.in[10][l * 32 + li_]) * 0.5f, d2 = wave_sum(a.in[11][l * 32 + li_] * a.in[12][l * 32 + li_]) * 0.5f;
    const float lam_init = 0.8f - 0.6f * expf(-0.3f * (float)l);
    u.lam = expf(d1) - expf(d2) + lam_init; u.cscale = 1.f - lam_init; u.gdiff = a.in[13] + l * 64;
    u.O = MIX + (size_t)b * SEQ * DM + 512 + 64 * h; u.op = DM;
    { const unsigned* KMAX = (const unsigned*)(a.ws + WS_CTL) + CW_KMAX + (b * 4 + h) * 2; u.pmm = (const float*)(a.ws + WS_PMM) + (size_t)b * 128;
      u.kn0 = sqrtf(__uint_as_float(KMAX[0])) * 1.02f; u.kn1 = sqrtf(__uint_as_float(KMAX[1])) * 1.02f; }
    att::attn_unit<1>(u, lds, tid);
}
__device__ __forceinline__ void run_unit_d(const MKArgs& a, LAS unsigned char* lds, int ud, const int tid) {
    const bf16_t* Z = (const bf16_t*)(a.ws + WS_ZH); bf16_t* MIX = (bf16_t*)(a.ws + WS_MIX); const bf16_t* KV = (const bf16_t*)(a.ws + WS_KV); const bf16_t* QD = (const bf16_t*)(a.ws + WS_QD);
    const int bh = ud >> 4, qblk = ud & 15, b = bh >> 2, h = bh & 3;
    att::Unit u; unit_common(u, a, b);
    u.i0 = 256 * qblk; u.kbase = 0; u.ntiles = SEQ / 64;
    const size_t rb = (size_t)b * SEQ;
    u.Q = QD + rb * 384 + 96 * h; u.qp = 384; u.K1 = KV + rb * 512 + 128 * h; u.k1p = 512; u.K2 = Z + rb * NZ + ZD_KR; u.k2p = NZ; u.V = KV + rb * 512 + 128 * h + 64; u.vp = 512;
    u.slope2 = 0.f; u.m_init = -1e20f; u.l_init = 0.f;
    u.O = MIX + rb * DM + 768 + 64 * h; u.op = DM;
    att::attn_unit<2>(u, lds, tid);
}
__device__ __forceinline__ void ph_merge_a(const MKArgs& a, int gtid, int gthreads, int b) {
    const bf16_t* OA = (const bf16_t*)(a.ws + WS_Y); const float* LSE = (const float*)(a.ws + WS_LSE); bf16_t* MIX = (bf16_t*)(a.ws + WS_MIX);
    for (int idx = gtid; idx < SEQ * 32; idx += gthreads) { const size_t row = (size_t)b * SEQ + (idx >> 5); const int ch = idx & 31, h = ch >> 3;
        const float l0 = LSE[row * 4 + h], l1 = LSE[((size_t)M + row) * 4 + h], l2 = LSE[((size_t)2 * M + row) * 4 + h];
        const float mx = fmaxf(l0, fmaxf(l1, l2)); float w0 = exp2f(l0 - mx), w1 = exp2f(l1 - mx), w2 = exp2f(l2 - mx); const float inv = 1.f / (w0 + w1 + w2); w0 *= inv; w1 *= inv; w2 *= inv;
        const u32x4 x0 = *(const u32x4*)(OA + row * 256 + 8 * ch), x1 = *(const u32x4*)(OA + ((size_t)M + row) * 256 + 8 * ch), x2 = *(const u32x4*)(OA + ((size_t)2 * M + row) * 256 + 8 * ch);
        u32x4 o;
#pragma unroll
        for (int e = 0; e < 4; ++e) { const float lo = w0 * __uint_as_float(x0[e] << 16) + w1 * __uint_as_float(x1[e] << 16) + w2 * __uint_as_float(x2[e] << 16);
            const float hi = w0 * __uint_as_float(x0[e] & 0xffff0000u) + w1 * __uint_as_float(x1[e] & 0xffff0000u) + w2 * __uint_as_float(x2[e] & 0xffff0000u); o[e] = cvtpk(lo, hi); }
        *(u32x4*)(MIX + row * DM + 8 * ch) = o; }
}

__global__ void __launch_bounds__(NTHREADS, 2) mk_fwd(MKArgs a) {
    extern __shared__ __attribute__((aligned(16))) unsigned char lds_raw[];
    LAS unsigned char* lds = (LAS unsigned char*)lds_raw;
    const int wid0 = __builtin_amdgcn_readfirstlane((int)(threadIdx.x >> 6));
    const int G = gridDim.x, bid = blockIdx.x, vcu = (G % 8 == 0) ? (bid % 8) * (G / 8) + bid / 8 : bid;
    unsigned char* ws = a.ws;
    float* MOD = (float*)(ws + WS_MOD); float* COS = (float*)(ws + WS_COS); float* SIN = (float*)(ws + WS_SIN); float* SS = (float*)(ws + WS_SS); float* YSS = (float*)(ws + WS_YSS);
    bf16_t* XN = (bf16_t*)(ws + WS_XN); bf16_t* ZH = (bf16_t*)(ws + WS_ZH); bf16_t* KV = (bf16_t*)(ws + WS_KV); bf16_t* QD = (bf16_t*)(ws + WS_QD); bf16_t* MIX = (bf16_t*)(ws + WS_MIX); bf16_t* Y = (bf16_t*)(ws + WS_Y);
    const float* x = a.in[0]; float* out = a.out;
    const int ngw = G * NWAVES;
    volatile LAS unsigned* MISC = (volatile LAS unsigned*)(lds + MISC_OFF);
    for (int u = threadIdx.x; u < 64; u += NTHREADS) MISC[u] = 0u;
    __syncthreads();
    XcdBarrier bar; bar.bar = (unsigned*)(ws + WS_CTL) + CW_BAR; bar.x = 0; bar.st = nullptr;
    if (a.ph_hi - a.ph_lo > 1) bar = xcd_barrier_post((unsigned*)(ws + WS_CTL) + CW_BAR, MISC + 8);
    for (int ph = a.ph_lo; ph < a.ph_hi; ++ph) {
        int tid; asm volatile("v_mbcnt_lo_u32_b32 %0, -1, 0\n\tv_mbcnt_hi_u32_b32 %0, -1, %0" : "=v"(tid)); tid += wid0 * 64;
        const int lane = tid & 63, wid = __builtin_amdgcn_readfirstlane(tid >> 6), gw = vcu * NWAVES + wid;
        if (ph == 0) { if (EN(8)) ph_prologue(a, lds, bid, G, tid); }
        else if (ph == 1) { if (EN(9)) { ElemArgs e{x, out, nullptr, nullptr, nullptr, MOD, 0, a.in[5], MOD, 1, 0, XN, 0, 1}; ph_elem0(e, gw, ngw, lane); ph_wconv(a, lds, bid, G, tid, 0, (WCONV_SPLIT && G == 256) ? 1 : DEPTH); } }
        else {
            const int l = (ph - 2) >> 3, st = (ph - 2) & 7;
            const bool loc = __builtin_amdgcn_readfirstlane((int)MISC[10]) != 0;
            const int vb = loc ? __builtin_amdgcn_readfirstlane((int)MISC[11]) * 8 + (int)bar.x : bid, vcu = (G % 8 == 0) ? (vb % 8) * (G / 8) + vb / 8 : vb;
            if (FUSE_E && (st == 4 || st == 7)) continue;
            const int xmask = a.xmask, ymask = a.ymask;
            const bf16_t* W = (const bf16_t*)(ws + WS_W + (size_t)l * W_LAYER); const float* modl = MOD + (size_t)l * 8 * 6144;
            pg8::StaticOrder S;
            const bool pjq = XQUEUE && a.xmask == 15 && (G & 7) == 0 && (G / 8) % PJ_DIV == 0, pjrole = !pjq || ((vb >> 3) % PJ_DIV == 0);
            const int pjG = pjq ? G / PJ_DIV : G, pjc = pjq ? ((vb >> 3) / PJ_DIV) * 8 + (vb & 7) : vb;
            if (st == 0 || (KRSPLIT && st == 1 && (xmask & 1) && pjrole)) { if (EN(0)) { const bool kr = (st == 1);
                pg8::Gemm g{XN, W + W_IN / 2 + (kr ? (size_t)2560 * DM : (size_t)0), M, KRSPLIT ? (kr ? 256 : 2560) : NZ, DM, DM, 0}; S.init(M, g.N, kr ? pjG : G, kr ? pjc : vb); EpiZ E{ZH, SS, COS, SIN, (unsigned*)(ws + WS_CTL) + CW_KMAX, kr ? 10 : 0}; pg8::gemm_phase<EpiZ, true>(lds, g, S, E, tid);
                if (WCONV_SPLIT && l == 0 && G == 256 && bid >= 128) ph_wconv(a, lds, bid - 128, 128, tid, 1, DEPTH); } }
            if (st == 1) {
                if (EN(1) && (xmask & 1) && pjrole) { pg8::Gemm g{ZH + ZD_CQ, W + W_UP / 2, M, NUP, KUP, NZ, 1}; S.init(M, NUP, pjG, pjc); EpiUp E{KV, QD, SS, COS, SIN}; pg8::gemm_phase<EpiUp, true>(lds, g, S, E, tid); }
                if (XQUEUE && xmask == 15 && (G & 7) == 0) {
                    const int qx = vb & 7, b = qx; unsigned* ctr = (unsigned*)(ws + WS_CTL) + CW_QUEUE + (l * 8 + qx) * 64;
                    unsigned nreg = 0u; if (tid == 0) nreg = atomicAdd(ctr, 1u);
                    if (tid == 0) MISC[16] = nreg;
                    __syncthreads(); int it = (int)MISC[16]; __syncthreads();
                    while (it < 320) {
                        if (tid == 0) nreg = atomicAdd(ctr, 1u);
                        if (it < 64) { const int h = 3 - (it >> 4), qb = it & 15; run_unit_c(a, lds, l, ((b * 4 + h) << 4) + qb, tid); }
                        else if (it < 128) { const int j = it - 64; run_unit_b(a, lds, l, ((b * 2 + (j >> 5)) << 5) + (j & 31), tid); }
                        else { const int j = it - 128, br = j >> 6, rem = j & 63; run_unit_a(a, lds, br, ((b * 4 + (rem >> 4)) << 4) + (rem & 15), tid); }
                        if (tid == 0) MISC[16] = nreg;
                        __syncthreads(); it = (int)MISC[16]; __syncthreads();
                    }
                } else {
                if (EN(12) && (xmask & 8)) for (int u = vcu; u < 512; u += G) run_unit_c(a, lds, l, u < 256 ? u : (u ^ 48), tid);
                if (EN(11) && (xmask & 4)) for (int u = vcu; u < 512; u += G) run_unit_b(a, lds, l, u, tid);
                if (EN(10) && (xmask & 2)) for (int br = 0; br < 3; ++br) for (int u = vcu; u < 512; u += G) run_unit_a(a, lds, br, u, tid);
                }
            }
            else if (st == 2) {
                if ((G & 7) == 0) {
                    const int db = vb & 7, dr = vb >> 3, gsz = G >> 3;
                    const int nu = dr < 64 ? (64 - dr + gsz - 1) / gsz : 0, mpos = (vb % 3) < nu ? (vb % 3) : nu;
                    for (int k = 0; k <= nu; ++k) {
                        if (k == mpos && EN(13) && (ymask & 2)) ph_merge_a(a, dr * NTHREADS + tid, gsz * NTHREADS, db);
                        if (k < nu && EN(2) && (ymask & 1)) run_unit_d(a, lds, (db << 6) + dr + k * gsz, tid); }
                } else {
                    const int nu = vcu < 512 ? (512 - vcu + G - 1) / G : 0;
                    for (int k = 0; k < nu; ++k) if (EN(2) && (ymask & 1)) run_unit_d(a, lds, vcu + k * G, tid);
                    if (EN(13) && (ymask & 2)) for (int b2 = 0; b2 < BATCH; ++b2) ph_merge_a(a, vcu * NTHREADS + tid, G * NTHREADS, b2);
                }
            }
            else if (st == 3) { if (EN(3)) { pg8::Gemm g{MIX, W + W_OUT / 2, M, DM, DM, DM, 0}; S.init(M, DM, G, vb);
                if (FUSE_E) { unsigned* cnt = (unsigned*)(ws + WS_CTL) + CW_CNT + (l * 4) * 8192; unsigned* slot = (unsigned*)YSS;
                    EpiFused E{l == 0 ? x : out, out, XN, a.in[6] + l * DM, modl, 2, a.in[19] + l * DM, modl, 4, 3, RowStat{slot, cnt}, RowStat{slot + (size_t)M * 4, cnt + 8192}, 1};
                    pg8::gemm_phase<EpiFused, true>(lds, g, S, E, tid); }
                else { EpiY E{Y, YSS}; pg8::gemm_phase<EpiY, true>(lds, g, S, E, tid); } } }
            else if (st == 4) { ElemArgs e{l == 0 ? x : out, out, Y, YSS, a.in[6] + l * DM, modl, 2, a.in[19] + l * DM, modl, 4, 3, XN, 1, 1}; ph_elem(e, gw, ngw, lane); }
            else if (st == 5) { if (EN(5)) { pg8::Gemm g{XN, W + W_GU / 2, M, NGU, DM, DM, 0}; S.init(M, NGU, G, vb); EpiH E{ZH}; pg8::gemm_phase<EpiH, true>(lds, g, S, E, tid); } }
            else if (st == 6) { if (EN(6)) { pg8::Gemm g{ZH, W + W_DN / 2, M, DM, DFF, DFF, 0}; S.init(M, DM, G, vb);
                if (FUSE_E) { const int ln = l + 1 < DEPTH ? l + 1 : l; unsigned* cnt = (unsigned*)(ws + WS_CTL) + CW_CNT + (l * 4 + 2) * 8192; unsigned* slot = (unsigned*)YSS;
                    EpiFused E{out, out, XN, a.in[20] + l * DM, modl, 5, a.in[5] + ln * DM, MOD + (size_t)ln * 8 * 6144, 1, 0, RowStat{slot, cnt}, RowStat{slot + (size_t)M * 4, cnt + 8192}, l + 1 < DEPTH ? 1 : 0};
                    pg8::gemm_phase<EpiFused, true>(lds, g, S, E, tid); }
                else { EpiY E{Y, YSS}; pg8::gemm_phase<EpiY, true>(lds, g, S, E, tid); } } }
            else if (st == 7) { const int ln = l + 1 < DEPTH ? l + 1 : l;
                ElemArgs e{out, out, Y, YSS, a.in[20] + l * DM, modl, 5, a.in[5] + ln * DM, MOD + (size_t)ln * 8 * 6144, 1, 0, XN, 1, l + 1 < DEPTH ? 1 : 0}; ph_elem(e, gw, ngw, lane); }
        }
        if (ph + 1 < a.ph_hi && !(FUSE_E && ph == NPH - 2)) { if (a.ph_lo < 0) cg::this_grid().sync(); else { int tb; asm volatile("v_mbcnt_lo_u32_b32 %0, -1, 0\n\tv_mbcnt_hi_u32_b32 %0, -1, %0" : "=v"(tb)); tb += wid0 * 64;
            if (ph >= 2 && __builtin_amdgcn_readfirstlane((int)MISC[10]) != 0) xcd_local_barrier(bar, (unsigned*)(ws + WS_CTL), tb); else xcd_barrier(bar, tb); } }
    }
}
extern "C" void kernel_launch(void* const* d_in, const int* in_sizes, int n_in, void* d_out, int out_size, void* d_ws, size_t ws_size, hipStream_t stream) {
    if (n_in != 23 || out_size != M * DM || ws_size < WS_END) { fprintf(stderr, "kernel_launch: unexpected shapes (n_in %d out %d ws %zu)\n", n_in, out_size, ws_size); return; }
    static int grid = 0;
    if (grid == 0) {
        int dev = 0, cus = 0, per_cu = 0;
        hipGetDevice(&dev); hipDeviceGetAttribute(&cus, hipDeviceAttributeMultiprocessorCount, dev);
        if (hipFuncSetAttribute((const void*)mk_fwd, hipFuncAttributeMaxDynamicSharedMemorySize, LDS_TOTAL) != hipSuccess) { fprintf(stderr, "kernel_launch: hipFuncSetAttribute failed\n"); grid = -1; return; }
        if (hipOccupancyMaxActiveBlocksPerMultiprocessor(&per_cu, (const void*)mk_fwd, NTHREADS, LDS_TOTAL) != hipSuccess || per_cu < 1) { fprintf(stderr, "kernel_launch: occupancy query says %d\n", per_cu); per_cu = 1; }
        (void)hipGetLastError();
        grid = cus * 1;
    }
    if (grid < 0) return;
    unsigned char* ws = (unsigned char*)d_ws; float* out = (float*)d_out;
    MKArgs a{};
    for (int i = 0; i < 23; ++i) a.in[i] = (const float*)d_in[i];
    a.out = out; a.ws = ws; a.xmask = 15; a.ymask = 3;
    if (hipMemsetAsync(ws + WS_CTL, 0, CTL_ZERO_BYTES, stream) != hipSuccess) { fprintf(stderr, "kernel_launch: memset failed\n"); return; }
    {
        a.ph_lo = 0; a.ph_hi = NPH; void* args[] = {&a};
        hipError_t e = hipLaunchCooperativeKernel((const void*)mk_fwd, dim3(grid), dim3(NTHREADS), args, LDS_TOTAL, stream);
        if (e != hipSuccess) fprintf(stderr, "cooperative launch failed: %s (grid %d)\n", hipGetErrorString(e), grid);
        return;
    }
}
```

```cpp
#include <hip/hip_runtime.h>
#include <cstdio>
#include <cstdint>

typedef unsigned short bf16_t;
typedef unsigned u32x4 __attribute__((ext_vector_type(4)));
typedef float f32x4 __attribute__((ext_vector_type(4)));

constexpr int BATCH = 8, SEQ = 4096, DM = 1024, DEPTH = 2, M = BATCH * SEQ;
constexpr int IN_W = 2592, NZ = 2816, DFF = 2816, NGU = 5632;
constexpr int NUP = 1024, KUP = 512;
constexpr float RMS_EPS = 1e-6f;
constexpr float LOG2E = 1.4426950408889634f;
constexpr int ZA_Q = 0, ZA_K = 256, ZA_V = 512, ZB_Q = 768, ZB_K = 1024, ZB_V = 1152, ZC_Q = 1280, ZC_K = 1536, ZC_V = 1792, ZD_CQ = 2048, ZD_CKV = 2432, ZD_KR = 2560;

constexpr size_t MiB = 1u << 20;
constexpr size_t WS_CTL = 0;
constexpr size_t WS_MOD = 1 * MiB;
constexpr size_t WS_COS = 2 * MiB, WS_SIN = 4 * MiB;
constexpr size_t WS_SS = 6 * MiB;
constexpr size_t WS_YSS = 8 * MiB;
constexpr size_t WS_LSE = 10 * MiB;
constexpr size_t WS_POSF = 1 * MiB + 512 * 1024;
constexpr size_t WS_PMM = 11 * MiB + 512 * 1024;
constexpr size_t WS_W = 12 * MiB;
constexpr size_t W_IN = 0, W_UP = 5632 * 1024, W_OUT = W_UP + 1 * MiB, W_GU = W_OUT + 2 * MiB, W_DN = W_GU + 11 * MiB, W_LAYER = 25 * MiB;
constexpr size_t WS_XN = 62 * MiB;
constexpr size_t WS_ZH = 126 * MiB;
constexpr size_t WS_KV = 302 * MiB;
constexpr size_t WS_QD = 334 * MiB;
constexpr size_t WS_MIX = 358 * MiB;
constexpr size_t WS_Y = 422 * MiB;
constexpr size_t WS_END = 486 * MiB;

__device__ __forceinline__ float bf2f(bf16_t v) { return __uint_as_float(((unsigned)v) << 16); }
__device__ __forceinline__ bf16_t f2bf(float f) { unsigned u = __float_as_uint(f); return (bf16_t)((u + 0x7fffu + ((u >> 16) & 1u)) >> 16); }
__device__ __forceinline__ float wave_sum(float v) {
#pragma unroll
    for (int o = 1; o < 64; o <<= 1) v += __shfl_xor(v, o);
    return v;
}
__host__ __device__ __forceinline__ float alibi_slope(int j  ) { return exp2f(-8.0f * (float)j / 12.0f); }

struct ElemArgs { const float* xin; float* xout; const bf16_t* Y; const float* YSS; const float* gpost; const float* modg; int gate_chunk; const float* gpre; const float* modn; int sc_chunk, sh_chunk; bf16_t* XN; int do_res, do_norm; };

#define LAS __attribute__((address_space(3)))
typedef short bf16x8 __attribute__((ext_vector_type(8)));
typedef float f32x16 __attribute__((ext_vector_type(16)));
typedef float f32x2 __attribute__((ext_vector_type(2)));
typedef int i32x4 __attribute__((ext_vector_type(4)));
typedef __bf16 bf16x2_t __attribute__((ext_vector_type(2)));
typedef short s16x4 __attribute__((ext_vector_type(4)));
__device__ __forceinline__ unsigned cvtpk(float lo, float hi) { f32x2 v = {lo, hi}; bf16x2_t b = __builtin_convertvector(v, bf16x2_t); return __builtin_bit_cast(unsigned, b); }
__device__ __forceinline__ u32x4 pack8(const f32x4& a, const f32x4& b) { u32x4 w; w.x = cvtpk(a[0], a[1]); w.y = cvtpk(a[2], a[3]); w.z = cvtpk(b[0], b[1]); w.w = cvtpk(b[2], b[3]); return w; }

namespace pg8 {
constexpr int BM = 256, BK = 64, HALF = 128, HTB = HALF * BK * 2, STAGE_BYTES = 8 * HTB, NXCD = 8, WGM = 8;
__host__ __device__ __forceinline__ int lds_byte(int r, int c) { const int st = (r >> 4) * 2 + (c >> 5), rr = r & 15, cc = c & 31, ob = rr * 64 + cc * 2; return st * 1024 + (ob ^ (((ob >> 9) & 1) << 5)); }
__host__ __device__ __forceinline__ void stage_rc(int b, int& R, int& C) { const int st = b / 1024, sb = b % 1024, swz = sb ^ (((sb >> 9) & 1) << 5); R = (st >> 1) * 16 + swz / 64; C = (st & 1) * 32 + (swz % 64) / 2; }
__host__ __device__ __forceinline__ int perm32(int rho) { const int n = rho >> 4, i = rho & 15; return 8 * (i >> 2) + 4 * n + (i & 3); }
struct Unit { int pm, pn; };
struct Gemm { const bf16_t* A; const bf16_t* Bt; int M, N, K, lda, ksplit; };
struct StaticOrder {
    int nM, nN, nwg, G, c;
    __device__ void init(int M_, int N_, int G_, int c_) { nM = M_ / BM; nN = N_ / BM; nwg = nM * nN; G = G_; c = c_; }
    __device__ bool next(int i, Unit& u) const {
        const long L = (long)i * G + c; if (L >= nwg) return false;
        int wgid = (int)L; { const int q = nwg / NXCD, r = nwg % NXCD, xcd = wgid % NXCD, off = wgid / NXCD; wgid = (xcd < r ? xcd * (q + 1) : r * (q + 1) + (xcd - r) * q) + off; }
        const int nig = WGM * nN, gid = wgid / nig, fm = gid * WGM, gsz = (nM - fm) < WGM ? (nM - fm) : WGM;
        u.pm = fm + ((wgid % nig) % gsz); u.pn = (wgid % nig) / gsz; return true;
    }
};
template <class Epi, bool ALIGN_EPI>
__device__ __forceinline__ void gemm_phase(LAS unsigned char* lds, const Gemm g, const StaticOrder& S, const Epi& E, const int tid) {
    const int wid = __builtin_amdgcn_readfirstlane(tid >> 6), lane = tid & 63, wr = wid >> 2, wc = wid & 3, fr = lane & 15, fq = lane >> 4;
    const int K = g.K, lda = g.lda; int nt = K / BK;
    unsigned voffA[2], voffB[2];
#pragma unroll
    for (int i = 0; i < 2; ++i) { int R, C; stage_rc(tid * 16 + i * 8192, R, C); const int Rb = (R & ~31) + perm32(R & 31);
        voffA[i] = (unsigned)(R * lda + C) * 2u; voffB[i] = (unsigned)(Rb * K + C) * 2u; }
    const size_t kstep = (size_t)(BK * 2);
    const size_t hstepA = (size_t)HALF * lda * 2, hstepB = (size_t)HALF * K * 2, tstepA = 2 * hstepA, tstepB = 2 * hstepB;
    const unsigned ldsw = (unsigned)wid * 1024u;
    const int aoff = lds_byte(wr * 64 + fr, fq * 8), boff = lds_byte(wc * 32 + fr, fq * 8);
#define PG8_SA(b, h) (((b) * 2 + (h)) * HTB)
#define PG8_SB(b, h) ((4 + (b) * 2 + (h)) * HTB)
#define PG8_STAGE(bufoff, gbase, voff) do { _Pragma("unroll") for (int _i = 0; _i < 2; ++_i) \
        __builtin_amdgcn_global_load_lds((const unsigned*)((const char*)(gbase) + (voff)[_i]), (LAS unsigned*)(lds + (bufoff) + ldsw + _i * 8192), 16, 0, 0); } while (0)
#define PG8_LDA(dst, b, h) do { _Pragma("unroll") for (int m = 0; m < 4; ++m) _Pragma("unroll") for (int k = 0; k < 2; ++k) dst[m][k] = *(const LAS bf16x8*)(lds + PG8_SA(b, h) + aoff + m * 2048 + k * 1024); } while (0)
#define PG8_LDB(dst, b, h) do { _Pragma("unroll") for (int n = 0; n < 2; ++n) _Pragma("unroll") for (int k = 0; k < 2; ++k) dst[n][k] = *(const LAS bf16x8*)(lds + PG8_SB(b, h) + boff + n * 2048 + k * 1024); } while (0)
#define PG8_MMA(ai, bj, At, Bt) do { __builtin_amdgcn_s_setprio(1); _Pragma("unroll") for (int m = 0; m < 4; ++m) _Pragma("unroll") for (int n = 0; n < 2; ++n) _Pragma("unroll") for (int k = 0; k < 2; ++k) \
        acc[ai][bj][m][n] = __builtin_amdgcn_mfma_f32_16x16x32_bf16(Bt[n][k], At[m][k], acc[ai][bj][m][n], 0, 0, 0); __builtin_amdgcn_s_setprio(0); } while (0)
#define PG8_WAIT_V(n) asm volatile("s_waitcnt vmcnt(" #n ")" ::: "memory")
#define PG8_WAIT_L(n) asm volatile("s_waitcnt lgkmcnt(" #n ")" ::: "memory")
#define PG8_BAR __builtin_amdgcn_s_barrier()
#define PG8_SCHED __builtin_amdgcn_sched_barrier(0)
    Unit cur, nxt; int ui = 0;
    if (!S.next(0, cur)) return;
    f32x4 acc[2][2][4][2];
#pragma unroll
    for (int a = 0; a < 2; ++a)
#pragma unroll
        for (int b = 0; b < 2; ++b)
#pragma unroll
            for (int m = 0; m < 4; ++m)
#pragma unroll
                for (int n = 0; n < 2; ++n) acc[a][b][m][n] = (f32x4){0.f, 0.f, 0.f, 0.f};
    bf16x8 At[4][2], B0[2][2], B1[2][2];
#define PG8_KBEG(u_) (g.ksplit ? ((u_).pn < 2 ? 512 : 0) : 0)
#define PG8_KNT(u_) (g.ksplit ? ((u_).pn < 2 ? 4 : 6) : K / BK)
    const char* cA = (const char*)g.A + (size_t)cur.pm * tstepA + PG8_KBEG(cur); const char* cB = (const char*)g.Bt + (size_t)cur.pn * tstepB + PG8_KBEG(cur); nt = PG8_KNT(cur);
    PG8_STAGE(PG8_SB(0, 0), cB, voffB); PG8_STAGE(PG8_SB(0, 1), cB + hstepB, voffB); PG8_STAGE(PG8_SA(0, 0), cA, voffA); PG8_STAGE(PG8_SA(0, 1), cA + hstepA, voffA);
    if (wr == 1) PG8_BAR;
    PG8_WAIT_V(2); PG8_BAR;
    PG8_STAGE(PG8_SB(1, 0), cB + kstep, voffB); PG8_STAGE(PG8_SA(1, 0), cA + kstep, voffA); PG8_STAGE(PG8_SB(1, 1), cB + hstepB + kstep, voffB);
    PG8_WAIT_V(6); PG8_BAR;
    for (;;) {
        const bool has_next = S.next(ui + 1, nxt);
        const char* nA = has_next ? (const char*)g.A + (size_t)nxt.pm * tstepA + PG8_KBEG(nxt) : cA; const char* nB = has_next ? (const char*)g.Bt + (size_t)nxt.pn * tstepB + PG8_KBEG(nxt) : cB;
        for (int t = 0; t < nt; t += 2) {
            const bool last = (t == nt - 2);
            const char* a1 = cA + (size_t)(t + 1) * kstep;
            const char* a2 = last ? nA : cA + (size_t)(t + 2) * kstep; const char* b2 = last ? nB : cB + (size_t)(t + 2) * kstep;
            const char* a3 = a2 + kstep; const char* b3 = b2 + kstep;
            PG8_LDB(B0, 0, 0); PG8_LDB(B1, 0, 1); PG8_SCHED; PG8_LDA(At, 0, 0); PG8_STAGE(PG8_SA(1, 1), a1 + hstepA, voffA);
            PG8_WAIT_V(8); PG8_WAIT_L(0); PG8_BAR; PG8_MMA(0, 0, At, B0); PG8_MMA(0, 1, At, B1); PG8_BAR; PG8_SCHED;
            PG8_LDA(At, 0, 1); PG8_STAGE(PG8_SB(0, 0), b2, voffB); PG8_STAGE(PG8_SB(0, 1), b2 + hstepB, voffB); PG8_STAGE(PG8_SA(0, 0), a2, voffA);
            PG8_WAIT_V(8); PG8_WAIT_L(0); PG8_BAR; PG8_MMA(1, 0, At, B0); PG8_MMA(1, 1, At, B1); PG8_BAR; PG8_SCHED;
            PG8_LDB(B0, 1, 0); PG8_LDB(B1, 1, 1); PG8_SCHED; PG8_LDA(At, 1, 0); PG8_STAGE(PG8_SA(0, 1), a2 + hstepA, voffA);
            PG8_WAIT_V(8); PG8_WAIT_L(0); PG8_BAR; PG8_MMA(0, 0, At, B0); PG8_MMA(0, 1, At, B1); PG8_BAR; PG8_SCHED;
            PG8_LDA(At, 1, 1); PG8_STAGE(PG8_SB(1, 0), b3, voffB); PG8_STAGE(PG8_SB(1, 1), b3 + hstepB, voffB); PG8_STAGE(PG8_SA(1, 0), a3, voffA);
            PG8_WAIT_V(8); PG8_WAIT_L(0); PG8_BAR; PG8_MMA(1, 0, At, B0); PG8_MMA(1, 1, At, B1); PG8_BAR; PG8_SCHED;
        }
        if constexpr (ALIGN_EPI) { if (wr == 0) PG8_BAR; }
        if constexpr (Epi::FUSED) E.fused(acc, cur, wr, wc, fr, fq, lds, wid, lane, tid); else E(acc, cur, wr, wc, fr, fq);
        if (!has_next) break;
#pragma unroll
        for (int a = 0; a < 2; ++a)
#pragma unroll
            for (int b = 0; b < 2; ++b)
#pragma unroll
                for (int m = 0; m < 4; ++m)
#pragma unroll
                    for (int n = 0; n < 2; ++n) acc[a][b][m][n] = (f32x4){0.f, 0.f, 0.f, 0.f};
        cur = nxt; cA = nA; cB = nB; ++ui; nt = PG8_KNT(cur);
        if constexpr (ALIGN_EPI) { if (wr == 1) PG8_BAR; }
    }
    PG8_WAIT_V(0);
    if constexpr (!ALIGN_EPI) { if (wr == 0) PG8_BAR; }
    PG8_BAR;
#undef PG8_KBEG
#undef PG8_KNT
#undef PG8_SA
#undef PG8_SB
#undef PG8_STAGE
#undef PG8_LDA
#undef PG8_LDB
#undef PG8_MMA
#undef PG8_WAIT_V
#undef PG8_WAIT_L
#undef PG8_BAR
#undef PG8_SCHED
}
}

__device__ __forceinline__ float sumsq8(const f32x4& a, const f32x4& b) { return ((a[0] * a[0] + a[1] * a[1]) + (a[2] * a[2] + a[3] * a[3])) + ((b[0] * b[0] + b[1] * b[1]) + (b[2] * b[2] + b[3] * b[3])); }
__device__ __forceinline__ void rope8(f32x4& v0, f32x4& v1, const float* cosr, const float* sinr, int fq) {
    const int i0 = 8 * (fq & 1);
    const f32x4 c0 = *(const f32x4*)(cosr + i0), c1 = *(const f32x4*)(cosr + i0 + 4), s0 = *(const f32x4*)(sinr + i0), s1 = *(const f32x4*)(sinr + i0 + 4);
    f32x4 p0, p1;
#pragma unroll
    for (int e = 0; e < 4; ++e) { p0[e] = __shfl_xor(v0[e], 32); p1[e] = __shfl_xor(v1[e], 32); }
    if (fq < 2) { v0 = v0 * c0 - p0 * s0; v1 = v1 * c1 - p1 * s1; }
    else        { v0 = p0 * s0 + v0 * c0; v1 = p1 * s1 + v1 * c1; }
}
struct EpiZ {
    static constexpr bool FUSED = false;
    bf16_t* Z; float* SS; const float* cosT; const float* sinT; unsigned* KMAX; int pn_off;
    __device__ __forceinline__ void operator()(const f32x4 (&acc)[2][2][4][2], const pg8::Unit& u_, int wr, int wc, int fr, int fq) const {
        pg8::Unit u = u_; u.pn += pn_off;
        const int row0 = u.pm * 256 + wr * 64 + fr, colb = u.pn * 256 + wc * 32 + 8 * fq;
        const bool rope = (u.pn == 10) && (wc == 0), ssq = (u.pn == 8) || (u.pn == 9);
#pragma unroll
        for (int ai = 0; ai < 2; ++ai)
#pragma unroll
            for (int m = 0; m < 4; ++m) { const int row = row0 + ai * 128 + m * 16;
                f32x4 a0 = acc[ai][0][m][0], a1 = acc[ai][0][m][1]; const f32x4 b0 = acc[ai][1][m][0], b1 = acc[ai][1][m][1];
                if (rope) rope8(a0, a1, cosT + (size_t)row * 16, sinT + (size_t)row * 16, fq);
                *(u32x4*)(Z + (size_t)row * NZ + colb) = pack8(a0, a1);
                *(u32x4*)(Z + (size_t)row * NZ + colb + 128) = pack8(b0, b1);
                if (ssq) { float s0 = sumsq8(a0, a1), s1 = sumsq8(b0, b1);
                    s0 += __shfl_xor(s0, 16); s0 += __shfl_xor(s0, 32); s1 += __shfl_xor(s1, 16); s1 += __shfl_xor(s1, 32);
                    if (fq == 0) { if (u.pn == 8) SS[(size_t)row * 12 + wc] = s0 + s1; else { SS[(size_t)row * 12 + 4 + wc] = s0; SS[(size_t)row * 12 + 8 + wc] = s1; } } }
                asm volatile("" ::: "memory");
            }
        if (u.pn == 6) {
            float mx0 = 0.f, mx1 = 0.f;
#pragma unroll
            for (int ai = 0; ai < 2; ++ai)
#pragma unroll
                for (int m = 0; m < 4; ++m) { float s0 = sumsq8(acc[ai][0][m][0], acc[ai][0][m][1]), s1 = sumsq8(acc[ai][1][m][0], acc[ai][1][m][1]);
                    s0 += __shfl_xor(s0, 16); s0 += __shfl_xor(s0, 32); s1 += __shfl_xor(s1, 16); s1 += __shfl_xor(s1, 32); mx0 = fmaxf(mx0, s0); mx1 = fmaxf(mx1, s1); }
#pragma unroll
            for (int o_ = 1; o_ < 16; o_ <<= 1) { mx0 = fmaxf(mx0, __shfl_xor(mx0, o_)); mx1 = fmaxf(mx1, __shfl_xor(mx1, o_)); }
            if (fr == 0 && fq == 0) { const int b = (u.pm * 256) / SEQ;
                atomicMax(KMAX + (b * 4 + (wc >> 1)) * 2 + (wc & 1), __float_as_uint(mx0)); atomicMax(KMAX + (b * 4 + 2 + (wc >> 1)) * 2 + (wc & 1), __float_as_uint(mx1)); }
        }
    }
};
struct EpiUp {
    static constexpr bool FUSED = false;
    bf16_t* KV; bf16_t* QD; const float* SS; const float* cosT; const float* sinT;
    __device__ __forceinline__ void operator()(const f32x4 (&acc)[2][2][4][2], const pg8::Unit& u, int wr, int wc, int fr, int fq) const {
        const int row0 = u.pm * 256 + wr * 64 + fr;
#pragma unroll
        for (int ai = 0; ai < 2; ++ai)
#pragma unroll
            for (int m = 0; m < 4; ++m) { const int row = row0 + ai * 128 + m * 16;
                const f32x4 sa = *(const f32x4*)(SS + (size_t)row * 12), sb = *(const f32x4*)(SS + (size_t)row * 12 + 4), sc = *(const f32x4*)(SS + (size_t)row * 12 + 8);
                if (u.pn < 2) {
                    const float rs = rsqrtf(((sc[0] + sc[1]) + (sc[2] + sc[3])) * (1.f / 128.f) + RMS_EPS);
#pragma unroll
                    for (int bj = 0; bj < 2; ++bj) *(u32x4*)(KV + (size_t)row * 512 + 256 * u.pn + 128 * bj + 32 * wc + 8 * fq) = pack8(acc[ai][bj][m][0] * rs, acc[ai][bj][m][1] * rs);
                } else {
                    const float rs = rsqrtf((((sa[0] + sa[1]) + (sa[2] + sa[3])) + ((sb[0] + sb[1]) + (sb[2] + sb[3]))) * (1.f / 384.f) + RMS_EPS);
#pragma unroll
                    for (int bj = 0; bj < 2; ++bj) { if (u.pn == 3 && bj == 1) continue;
                        const int c0 = 256 * (u.pn - 2) + 128 * bj + 32 * wc;
                        f32x4 v0 = acc[ai][bj][m][0] * rs, v1 = acc[ai][bj][m][1] * rs;
                        if ((c0 % 96) == 64) rope8(v0, v1, cosT + (size_t)row * 16, sinT + (size_t)row * 16, fq);
                        *(u32x4*)(QD + (size_t)row * 384 + c0 + 8 * fq) = pack8(v0, v1); }
                }
                asm volatile("" ::: "memory");
            }
    }
};
struct EpiY {
    static constexpr bool FUSED = false;
    bf16_t* Y; float* YSS;
    __device__ __forceinline__ void operator()(const f32x4 (&acc)[2][2][4][2], const pg8::Unit& u, int wr, int wc, int fr, int fq) const {
        const int row0 = u.pm * 256 + wr * 64 + fr, colb = u.pn * 256 + wc * 32 + 8 * fq;
#pragma unroll
        for (int ai = 0; ai < 2; ++ai)
#pragma unroll
            for (int m = 0; m < 4; ++m) { const int row = row0 + ai * 128 + m * 16;
                *(u32x4*)(Y + (size_t)row * DM + colb) = pack8(acc[ai][0][m][0], acc[ai][0][m][1]);
                *(u32x4*)(Y + (size_t)row * DM + colb + 128) = pack8(acc[ai][1][m][0], acc[ai][1][m][1]);
                float s = sumsq8(acc[ai][0][m][0], acc[ai][0][m][1]) + sumsq8(acc[ai][1][m][0], acc[ai][1][m][1]);
                s += __shfl_xor(s, 16); s += __shfl_xor(s, 32);
                if (fq == 0) YSS[(size_t)row * 16 + 4 * u.pn + wc] = s; }
    }
};
__device__ __forceinline__ float silu_mul(float g, float u) { return g * __builtin_amdgcn_rcpf(1.f + __builtin_amdgcn_exp2f(-g * LOG2E)) * u; }
struct EpiH {
    static constexpr bool FUSED = false;
    bf16_t* H;
    __device__ __forceinline__ void operator()(const f32x4 (&acc)[2][2][4][2], const pg8::Unit& u, int wr, int wc, int fr, int fq) const {
        const int row0 = u.pm * 256 + wr * 64 + fr, colb = u.pn * 128 + wc * 32 + 8 * fq;
#pragma unroll
        for (int ai = 0; ai < 2; ++ai)
#pragma unroll
            for (int m = 0; m < 4; ++m) { const int row = row0 + ai * 128 + m * 16; f32x4 h0, h1;
#pragma unroll
                for (int e = 0; e < 4; ++e) { h0[e] = silu_mul(acc[ai][0][m][0][e], acc[ai][1][m][0][e]); h1[e] = silu_mul(acc[ai][0][m][1][e], acc[ai][1][m][1][e]); }
                *(u32x4*)(H + (size_t)row * DFF + colb) = pack8(h0, h1); }
    }
};

constexpr int TAB_OFF = 131072 + 1024;
struct RowStat {
    unsigned* slot; unsigned* cnt;
    __device__ __forceinline__ void run(const float (&part)[8], const pg8::Unit& u, int wr, int wc, int fr, int fq, LAS unsigned char* lds, int wid, int lane, int tid_) const {
        int tid = tid_; asm volatile("" : "+v"(tid));
        LAS float* P = (LAS float*)(lds + TAB_OFF); LAS float* S = (LAS float*)(lds + TAB_OFF + 4096);
#pragma unroll
        for (int i = 0; i < 8; ++i) { float v = part[i]; v += __shfl_xor(v, 16); v += __shfl_xor(v, 32); if (fq == 0) P[((i >> 2) * 128 + wr * 64 + (i & 3) * 16 + fr) * 4 + wc] = v; }
        asm volatile("s_waitcnt lgkmcnt(0)" ::: "memory"); __builtin_amdgcn_s_barrier(); asm volatile("" ::: "memory");
        if (wid < 4) {
            const f32x4 p4 = *(const LAS f32x4*)(P + tid * 4);
            __hip_atomic_store(slot + ((size_t)(u.pm * 256 + tid)) * 4 + u.pn, __float_as_uint((p4[0] + p4[1]) + (p4[2] + p4[3])), __ATOMIC_RELAXED, __HIP_MEMORY_SCOPE_AGENT);
            asm volatile("s_waitcnt vmcnt(0)" ::: "memory");
            if (lane == 0) __hip_atomic_fetch_add(cnt + 64 * u.pm, 1u, __ATOMIC_RELAXED, __HIP_MEMORY_SCOPE_AGENT);
        }
        if (wid == 0) {
            unsigned spins = 0;
            while ((unsigned)__builtin_amdgcn_readfirstlane(__hip_atomic_load(cnt + 64 * u.pm, __ATOMIC_RELAXED, __HIP_MEMORY_SCOPE_AGENT)) < 16u) { __builtin_amdgcn_s_sleep(2); if (++spins > (1u << 20)) break; }
            __builtin_amdgcn_fence(__ATOMIC_ACQUIRE, "agent");
        }
        asm volatile("s_waitcnt vmcnt(0) lgkmcnt(0)" ::: "memory"); __builtin_amdgcn_s_barrier(); asm volatile("" ::: "memory");
        if (wid < 4) { const unsigned* sp = slot + ((size_t)(u.pm * 256 + tid)) * 4; float t = 0.f;
#pragma unroll
            for (int k = 0; k < 4; ++k) t += __uint_as_float(__hip_atomic_load(sp + k, __ATOMIC_RELAXED, __HIP_MEMORY_SCOPE_AGENT));
            S[tid] = t; }
        asm volatile("s_waitcnt lgkmcnt(0)" ::: "memory"); __builtin_amdgcn_s_barrier(); asm volatile("" ::: "memory");
    }
};
struct EpiFused {
    static constexpr bool FUSED = true;
    const float* xin; float* xout; bf16_t* XN; const float* gpost; const float* modg; int gate_chunk; const float* gpre; const float* modn; int sc_chunk, sh_chunk; RowStat stA, stC; int do_norm;
    __device__ __forceinline__ void fused(f32x4 (&acc)[2][2][4][2], const pg8::Unit& u, int wr, int wc, int fr, int fq, LAS unsigned char* lds, int wid, int lane, int tid) const {
        int frv = fr, fqv = fq; asm volatile("" : "+v"(frv), "+v"(fqv));
        const int b = (u.pm * 256) / SEQ, rloc0 = wr * 64 + frv, colb = u.pn * 256 + wc * 32 + 8 * fqv;
        const LAS float* S = (const LAS float*)(lds + TAB_OFF + 4096);
        float part[8];
#pragma unroll
        for (int i = 0; i < 8; ++i) part[i] = sumsq8(acc[i >> 2][0][i & 3][0], acc[i >> 2][0][i & 3][1]) + sumsq8(acc[i >> 2][1][i & 3][0], acc[i >> 2][1][i & 3][1]);
        stA.run(part, u, wr, wc, fr, fq, lds, wid, lane, tid);
        { f32x4 gg[2][2];
#pragma unroll
          for (int bj = 0; bj < 2; ++bj)
#pragma unroll
            for (int n = 0; n < 2; ++n) gg[bj][n] = *(const f32x4*)(modg + (size_t)b * 6144 + gate_chunk * 1024 + colb + 128 * bj + 4 * n) * *(const f32x4*)(gpost + colb + 128 * bj + 4 * n);
#pragma unroll
          for (int ai = 0; ai < 2; ++ai)
#pragma unroll
            for (int m = 0; m < 4; ++m) { const int rl = ai * 128 + rloc0 + m * 16; const float rs = rsqrtf(S[rl] * (1.f / DM) + RMS_EPS); const size_t off = (size_t)(u.pm * 256 + rl) * DM + colb;
#pragma unroll
                for (int bj = 0; bj < 2; ++bj)
#pragma unroll
                    for (int n = 0; n < 2; ++n) { const f32x4 xo = *(const f32x4*)(xin + off + 128 * bj + 4 * n); const f32x4 xn = xo + acc[ai][bj][m][n] * (gg[bj][n] * rs); acc[ai][bj][m][n] = xn; *(f32x4*)(xout + off + 128 * bj + 4 * n) = xn; }
                asm volatile("" ::: "memory"); } }
        if (!do_norm) return;
#pragma unroll
        for (int i = 0; i < 8; ++i) part[i] = sumsq8(acc[i >> 2][0][i & 3][0], acc[i >> 2][0][i & 3][1]) + sumsq8(acc[i >> 2][1][i & 3][0], acc[i >> 2][1][i & 3][1]);
        stC.run(part, u, wr, wc, fr, fq, lds, wid, lane, tid);
        { f32x4 gs[2][2], sh[2][2];
#pragma unroll
          for (int bj = 0; bj < 2; ++bj)
#pragma unroll
            for (int n = 0; n < 2; ++n) { const int c = colb + 128 * bj + 4 * n; gs[bj][n] = *(const f32x4*)(gpre + c) * (*(const f32x4*)(modn + (size_t)b * 6144 + sc_chunk * 1024 + c) + 1.f); sh[bj][n] = *(const f32x4*)(modn + (size_t)b * 6144 + sh_chunk * 1024 + c); }
#pragma unroll
          for (int ai = 0; ai < 2; ++ai)
#pragma unroll
            for (int m = 0; m < 4; ++m) { const int rl = ai * 128 + rloc0 + m * 16; const float rs = rsqrtf(S[rl] * (1.f / DM) + RMS_EPS); const size_t off = (size_t)(u.pm * 256 + rl) * DM + colb;
#pragma unroll
                for (int bj = 0; bj < 2; ++bj) *(u32x4*)(XN + off + 128 * bj) = pack8(acc[ai][bj][m][0] * (gs[bj][0] * rs) + sh[bj][0], acc[ai][bj][m][1] * (gs[bj][1] * rs) + sh[bj][1]);
            } }
    }
};

namespace att {
constexpr int STG = 21504, OFF_V = 12288, OFF_KPOS = 20480, NBUF = 6, WSF_OFF = NBUF * STG, LDS_BYTES = WSF_OFF + 8 * 256;
constexpr float THR = 8.f;
constexpr float SKIP_T = 24.f;
constexpr int MASK_OFF = 131072 + 512;
struct Unit {
    const bf16_t* Q; int qp; const bf16_t* K1; int k1p; const bf16_t* K2; int k2p; const bf16_t* V; int vp;
    const float* posf; int r, d, n, i0, kbase, ntiles, radius;
    float slope2, m_init, l_init;
    bf16_t* O; int op; float* lse; float lam, cscale; const float* gdiff;
    int hsplit; float slope2b, m_initb;
    const float* pmm; float kn0, kn1;
};
__device__ __forceinline__ float mx3(float a, float b, float c) { return fmaxf(fmaxf(a, b), c); }
__device__ __forceinline__ float fma_abs(float a, float d, float c) { float r; asm("v_fma_f32 %0, %1, |%2|, %3" : "=v"(r) : "v"(a), "v"(d), "v"(c)); return r; }
__device__ __forceinline__ s16x4 vtr(const LAS unsigned char* p) { return __builtin_bit_cast(s16x4, __builtin_amdgcn_ds_read_tr16_b64_v4i16((LAS s16x4*)p)); }
__device__ __forceinline__ float xhalf(float v, bool sum) { auto rr = __builtin_amdgcn_permlane32_swap(__float_as_uint(v), __float_as_uint(v), false, false);
    const float a = __uint_as_float(rr[0]), b = __uint_as_float(rr[1]); return sum ? a + b : fmaxf(a, b); }
__device__ __forceinline__ void glds16(const void* gsrc, unsigned lds_dst) { unsigned keep;
    asm volatile("s_mov_b32 %0, m0\n\ts_mov_b32 m0, %2\n\ts_nop 0\n\tglobal_load_lds_dwordx4 %1, off\n\ts_mov_b32 m0, %0" : "=&s"(keep) : "v"(gsrc), "s"(lds_dst) : "memory"); }
__device__ __forceinline__ void glds4(const void* gsrc, unsigned lds_dst) { unsigned keep;
    asm volatile("s_mov_b32 %0, m0\n\ts_mov_b32 m0, %2\n\ts_nop 0\n\tglobal_load_lds_dword %1, off\n\ts_mov_b32 m0, %0" : "=&s"(keep) : "v"(gsrc), "s"(lds_dst) : "memory"); }
template <int MODE>
__device__ __forceinline__ void attn_unit(const Unit& u, LAS unsigned char* lds, const int tid) {
    constexpr int DQK = (MODE == 2) ? 96 : 64, NMAP = (MODE == 1) ? 2 : 1, ND0 = DQK / 16;
    const int lane = tid & 63, r32 = lane & 31, hi = lane >> 5, wid = __builtin_amdgcn_readfirstlane(tid >> 6);
    LAS float* wsf = (LAS float*)(lds + WSF_OFF) + wid * 64;
    const int wrow = (MODE == 0 && u.hsplit) ? (wid & 3) : wid, hh = (MODE == 0 && u.hsplit) ? (wid >> 2) : 0;
    const float slope2 = (MODE == 0 && hh) ? u.slope2b : u.slope2;
    const int qi = u.i0 + 32 * wrow + r32, qtok = u.r + u.d * qi;
    bf16x8 q[ND0];
#pragma unroll
    for (int d0 = 0; d0 < ND0; ++d0) q[d0] = *(const bf16x8*)(u.Q + (size_t)qtok * u.qp + 64 * hh + 16 * d0 + 8 * hi);
    float pq = (MODE != 2) ? u.posf[qtok] : 0.f;
#pragma unroll
    for (int d0 = 0; d0 < ND0; ++d0) asm volatile("" : "+v"(q[d0]));
    asm volatile("" : "+v"(pq));
    const unsigned lds0 = (unsigned)(uintptr_t)lds;
#define ATT_LOAD(j, buf) do { const unsigned st_ = (unsigned)__builtin_amdgcn_readfirstlane((int)(lds0 + (unsigned)(buf) * STG)); \
        { int idx = u.kbase + 64 * (j) + lane; idx = idx < 0 ? 0 : (idx > u.n - 1 ? u.n - 1 : idx); const size_t tok = (size_t)(u.r + u.d * idx); \
            glds16(u.K1 + tok * u.k1p + 8 * wid, st_ + wid * 1024); \
            if (MODE == 2 && wid < 4) glds16(u.K2 + tok * u.k2p + 8 * wid, st_ + (8 + wid) * 1024); \
            if (MODE != 2 && wid == 7) glds4(u.posf + tok, st_ + OFF_KPOS); } \
        { int idx = u.kbase + 64 * (j) + 16 * (wid & 3) + (lane >> 2); idx = idx < 0 ? 0 : (idx > u.n - 1 ? u.n - 1 : idx); const size_t tok = (size_t)(u.r + u.d * idx); \
            glds16(u.V + tok * u.vp + 32 * (wid >> 2) + 8 * (lane & 3), st_ + OFF_V + wid * 1024); } } while (0)
#define ATT_STORE(buf) do { } while (0)
#define ATT_SYNC() asm volatile("s_waitcnt vmcnt(0) lgkmcnt(0)\n\ts_barrier" ::: "memory")
    float m_run[NMAP], l_run[NMAP]; f32x16 o[NMAP][2];
#pragma unroll
    for (int mp = 0; mp < NMAP; ++mp) { m_run[mp] = MODE != 0 ? 0.f : ((MODE == 0 && hh) ? u.m_initb : u.m_init); l_run[mp] = hi == 0 ? u.l_init : 0.f; o[mp][0] = f32x16{}; o[mp][1] = f32x16{}; }
    float mlb[NMAP];
#pragma unroll
    for (int mp = 0; mp < NMAP; ++mp) mlb[mp] = -1e30f;
    int j_lo = 0, j_hi = u.ntiles - 1;
    if (MODE == 0) { j_lo = wrow >> 1; j_hi = (32 * wrow + 31 + 2 * u.radius) >> 6; }
    constexpr int NPASS = (MODE == 1) ? 2 : 1;
    constexpr bool STAG = (MODE != 1);
    const bool late = STAG && (wid >= 4);
    bf16x8 pa[4]; bool pend = false; int bprev = 0; bool first = true;
    f32x16 negm = f32x16{};
    if (MODE == 2) { float z_ = 0.f; asm volatile("" : "+v"(z_));
#pragma unroll
        for (int r = 0; r < 16; ++r) negm[r] = z_; }
#define ATT_PV(stp, oacc) do { unsigned vbo = (unsigned)(uintptr_t)((stp) + OFF_V + ((lane >> 4) & 1) * 32 + (lane & 3) * 8 + (4 * hi + ((lane & 15) >> 2)) * 64); asm volatile("" : "+v"(vbo)); \
        const LAS unsigned char* vbm = (const LAS unsigned char*)(uintptr_t)vbo; \
        _Pragma("unroll") for (int dblk = 0; dblk < 2; ++dblk) _Pragma("unroll") for (int s4 = 0; s4 < 4; ++s4) { \
            const s16x4 lo = vtr(vbm + dblk * 4096 + s4 * 1024), hh = vtr(vbm + dblk * 4096 + s4 * 1024 + 512); \
            const bf16x8 bv = {lo[0], lo[1], lo[2], lo[3], hh[0], hh[1], hh[2], hh[3]}; \
            (oacc)[dblk] = __builtin_amdgcn_mfma_f32_32x32x16_bf16(pa[s4], bv, (oacc)[dblk], 0, 0, 0); } } while (0)
#pragma unroll 1
    for (int pass = 0; pass < NPASS; ++pass) {
        unsigned long long bm, wm;
        if (MODE == 1) {
            const unsigned long long diag = 0xFull << (u.i0 >> 6);
            if (pass == 0) { bm = diag; wm = diag; }
            else {
                float qn0, qn1, pqmin = pq, pqmax = pq;
                { float s0 = 0.f, s1 = 0.f;
#pragma unroll
                  for (int e = 0; e < 8; ++e) { const float a0 = bf2f((bf16_t)q[0][e]), a1 = bf2f((bf16_t)q[1][e]), b0 = bf2f((bf16_t)q[ND0 - 2][e]), b1 = bf2f((bf16_t)q[ND0 - 1][e]); s0 += a0 * a0 + a1 * a1; s1 += b0 * b0 + b1 * b1; }
                  s0 = xhalf(s0, true); s1 = xhalf(s1, true);
#pragma unroll
                  for (int o_ = 1; o_ < 32; o_ <<= 1) { s0 = fmaxf(s0, __shfl_xor(s0, o_)); s1 = fmaxf(s1, __shfl_xor(s1, o_)); pqmin = fminf(pqmin, __shfl_xor(pqmin, o_)); pqmax = fmaxf(pqmax, __shfl_xor(pqmax, o_)); }
                  qn0 = sqrtf(s0); qn1 = sqrtf(s1); }
                float ml0 = mlb[0], ml1 = mlb[NMAP - 1];
#pragma unroll
                for (int o_ = 1; o_ < 32; o_ <<= 1) { ml0 = fminf(ml0, __shfl_xor(ml0, o_)); ml1 = fminf(ml1, __shfl_xor(ml1, o_)); }
                const float pmn = u.pmm[2 * lane], pmx = u.pmm[2 * lane + 1];
                const float pen = u.slope2 * fmaxf(0.f, fmaxf(pmn - pqmax, pqmin - pmx));
                const bool need = (qn0 * u.kn0 - pen >= ml0 - SKIP_T) || (qn1 * u.kn1 - pen >= ml1 - SKIP_T);
                wm = __ballot(need) & ~diag;
                LAS unsigned long long* mk = (LAS unsigned long long*)(lds + MASK_OFF);
                if (lane == 0) mk[wid] = wm;
                __syncthreads();
                unsigned long long un = 0ull;
#pragma unroll
                for (int w = 0; w < 8; ++w) un |= mk[w];
                bm = ((unsigned long long)(unsigned)__builtin_amdgcn_readfirstlane((int)(un >> 32)) << 32) | (unsigned)__builtin_amdgcn_readfirstlane((int)un);
            }
        } else {
            bm = u.ntiles >= 64 ? ~0ull : ((1ull << u.ntiles) - 1ull);
            wm = bm; if (MODE == 0) wm = (j_hi >= 63 ? ~0ull : ((1ull << (j_hi + 1)) - 1ull)) & ~((1ull << j_lo) - 1ull);
        }
        if (bm == 0ull) continue;
        const bool preload = (MODE == 0) && (u.ntiles <= NBUF);
        if (preload) {
#pragma unroll 1
            for (int t = 0; t < u.ntiles; ++t) { ATT_LOAD(t, t); asm volatile("" ::: "memory"); }
        }
        int j = __builtin_ctzll(bm); bm &= bm - 1ull; int buf = 0;
        if (!preload) { ATT_LOAD(j, 0); ATT_STORE(0); }
        ATT_SYNC();
        for (;;) {
        const bool more = bm != 0ull; int jn = 0; const int bnext = buf == NBUF - 1 ? 0 : buf + 1;
        if (more) { jn = __builtin_ctzll(bm); bm &= bm - 1ull; if (!preload) ATT_LOAD(jn, bnext); }
        if (STAG && late && pend) { ATT_PV(lds + bprev * STG, o[0]); pend = false; }
        if (MODE == 1 && ((wm >> j) & 1ull)) {
            const LAS unsigned char* st = lds + buf * STG;
            const LAS unsigned char* kb = st + hi * 1024 + r32 * 16;
            f32x16 bia0, bia1;
            { const float nsl = -slope2, nref = -m_run[0];
#pragma unroll
              for (int g = 0; g < 4; ++g) {
                const f32x4 ka = *(const LAS f32x4*)(st + OFF_KPOS + 4 * (8 * g + 4 * hi)), kb4 = *(const LAS f32x4*)(st + OFF_KPOS + 4 * (32 + 8 * g + 4 * hi));
#pragma unroll
                for (int e = 0; e < 4; ++e) { bia0[4 * g + e] = fma_abs(nsl, pq - ka[e], nref); bia1[4 * g + e] = fma_abs(nsl, pq - kb4[e], nref); } } }
            f32x16 pA0, pA1, pB0, pB1;
            { const bf16x8 a0 = *(const LAS bf16x8*)(kb + 0 * 2048), a1 = *(const LAS bf16x8*)(kb + 0 * 2048 + 512), b0 = *(const LAS bf16x8*)(kb + 2 * 2048), b1 = *(const LAS bf16x8*)(kb + 2 * 2048 + 512);
              pA0 = __builtin_amdgcn_mfma_f32_32x32x16_bf16(a0, q[0], bia0, 0, 0, 0); pA1 = __builtin_amdgcn_mfma_f32_32x32x16_bf16(a1, q[0], bia1, 0, 0, 0);
              pB0 = __builtin_amdgcn_mfma_f32_32x32x16_bf16(b0, q[ND0 - 2], bia0, 0, 0, 0); pB1 = __builtin_amdgcn_mfma_f32_32x32x16_bf16(b1, q[ND0 - 2], bia1, 0, 0, 0); }
            { const bf16x8 a0 = *(const LAS bf16x8*)(kb + 1 * 2048), a1 = *(const LAS bf16x8*)(kb + 1 * 2048 + 512), b0 = *(const LAS bf16x8*)(kb + 3 * 2048), b1 = *(const LAS bf16x8*)(kb + 3 * 2048 + 512);
              pA0 = __builtin_amdgcn_mfma_f32_32x32x16_bf16(a0, q[1], pA0, 0, 0, 0); pA1 = __builtin_amdgcn_mfma_f32_32x32x16_bf16(a1, q[1], pA1, 0, 0, 0);
              pB0 = __builtin_amdgcn_mfma_f32_32x32x16_bf16(b0, q[ND0 - 1], pB0, 0, 0, 0); pB1 = __builtin_amdgcn_mfma_f32_32x32x16_bf16(b1, q[ND0 - 1], pB1, 0, 0, 0); }
            float rmA, rmB;
            { float ra = mx3(pA0[0], pA0[1], pA1[0]), rb = mx3(pA0[2], pA0[3], pA1[1]); ra = mx3(ra, pA1[2], pA1[3]);
#pragma unroll
              for (int r = 4; r < 16; r += 4) { ra = mx3(ra, pA0[r], pA0[r + 1]); rb = mx3(rb, pA0[r + 2], pA0[r + 3]); ra = mx3(ra, pA1[r], pA1[r + 1]); rb = mx3(rb, pA1[r + 2], pA1[r + 3]); }
              rmA = xhalf(fmaxf(ra, rb), false); }
            { float ra = mx3(pB0[0], pB0[1], pB1[0]), rb = mx3(pB0[2], pB0[3], pB1[1]); ra = mx3(ra, pB1[2], pB1[3]);
#pragma unroll
              for (int r = 4; r < 16; r += 4) { ra = mx3(ra, pB0[r], pB0[r + 1]); rb = mx3(rb, pB0[r + 2], pB0[r + 3]); ra = mx3(ra, pB1[r], pB1[r + 1]); rb = mx3(rb, pB1[r + 2], pB1[r + 3]); }
              rmB = xhalf(fmaxf(ra, rb), false); }
            mlb[0] = fmaxf(mlb[0], rmA + m_run[0]); mlb[NMAP - 1] = fmaxf(mlb[NMAP - 1], rmB + m_run[0]);
            const float rm = fmaxf(rmA, rmB);
            if (first || __any(rm > THR)) {
                const float dl = first ? rm : fmaxf(rm, 0.f); m_run[0] += dl;
#pragma unroll
                for (int r = 0; r < 16; ++r) { pA0[r] -= dl; pA1[r] -= dl; pB0[r] -= dl; pB1[r] -= dl; }
                if (!first) { const float f = __builtin_amdgcn_exp2f(-dl); l_run[0] *= f; l_run[NMAP - 1] *= f; if (hi == 0) wsf[r32] = f;
                    __builtin_amdgcn_wave_barrier();
#pragma unroll
                    for (int g = 0; g < 4; ++g) { const f32x4 f4 = *(const LAS f32x4*)(wsf + 8 * g + 4 * hi);
#pragma unroll
                        for (int e = 0; e < 4; ++e) { o[0][0][4 * g + e] *= f4[e]; o[0][1][4 * g + e] *= f4[e]; o[NMAP - 1][0][4 * g + e] *= f4[e]; o[NMAP - 1][1][4 * g + e] *= f4[e]; } }
                    __builtin_amdgcn_wave_barrier(); }
                first = false;
            }
            float sA = 0.f, sB = 0.f;
#pragma unroll
            for (int r = 0; r < 16; ++r) { pA0[r] = __builtin_amdgcn_exp2f(pA0[r]); pA1[r] = __builtin_amdgcn_exp2f(pA1[r]); sA += pA0[r] + pA1[r]; pB0[r] = __builtin_amdgcn_exp2f(pB0[r]); pB1[r] = __builtin_amdgcn_exp2f(pB1[r]); sB += pB0[r] + pB1[r]; }
            l_run[0] += sA; l_run[NMAP - 1] += sB;
            bf16x8 paA[4], paB[4];
#pragma unroll
            for (int s2 = 0; s2 < 2; ++s2) {
                u32x4 w; w.x = cvtpk(pA0[8 * s2], pA0[8 * s2 + 1]); w.y = cvtpk(pA0[8 * s2 + 2], pA0[8 * s2 + 3]); w.z = cvtpk(pA0[8 * s2 + 4], pA0[8 * s2 + 5]); w.w = cvtpk(pA0[8 * s2 + 6], pA0[8 * s2 + 7]); paA[s2] = __builtin_bit_cast(bf16x8, w);
                u32x4 x; x.x = cvtpk(pA1[8 * s2], pA1[8 * s2 + 1]); x.y = cvtpk(pA1[8 * s2 + 2], pA1[8 * s2 + 3]); x.z = cvtpk(pA1[8 * s2 + 4], pA1[8 * s2 + 5]); x.w = cvtpk(pA1[8 * s2 + 6], pA1[8 * s2 + 7]); paA[2 + s2] = __builtin_bit_cast(bf16x8, x);
                u32x4 y; y.x = cvtpk(pB0[8 * s2], pB0[8 * s2 + 1]); y.y = cvtpk(pB0[8 * s2 + 2], pB0[8 * s2 + 3]); y.z = cvtpk(pB0[8 * s2 + 4], pB0[8 * s2 + 5]); y.w = cvtpk(pB0[8 * s2 + 6], pB0[8 * s2 + 7]); paB[s2] = __builtin_bit_cast(bf16x8, y);
                u32x4 z; z.x = cvtpk(pB1[8 * s2], pB1[8 * s2 + 1]); z.y = cvtpk(pB1[8 * s2 + 2], pB1[8 * s2 + 3]); z.z = cvtpk(pB1[8 * s2 + 4], pB1[8 * s2 + 5]); z.w = cvtpk(pB1[8 * s2 + 6], pB1[8 * s2 + 7]); paB[2 + s2] = __builtin_bit_cast(bf16x8, z); }
            { unsigned vbo = (unsigned)(uintptr_t)(st + OFF_V + ((lane >> 4) & 1) * 32 + (lane & 3) * 8 + (4 * hi + ((lane & 15) >> 2)) * 64); asm volatile("" : "+v"(vbo));
              const LAS unsigned char* vbm = (const LAS unsigned char*)(uintptr_t)vbo;
#pragma unroll
              for (int dblk = 0; dblk < 2; ++dblk)
#pragma unroll
                for (int s4 = 0; s4 < 4; ++s4) {
                    const s16x4 lo = vtr(vbm + dblk * 4096 + s4 * 1024), hh2 = vtr(vbm + dblk * 4096 + s4 * 1024 + 512);
                    const bf16x8 bv = {lo[0], lo[1], lo[2], lo[3], hh2[0], hh2[1], hh2[2], hh2[3]};
                    o[0][dblk] = __builtin_amdgcn_mfma_f32_32x32x16_bf16(paA[s4], bv, o[0][dblk], 0, 0, 0); o[NMAP - 1][dblk] = __builtin_amdgcn_mfma_f32_32x32x16_bf16(paB[s4], bv, o[NMAP - 1][dblk], 0, 0, 0); } }
        } else
        if ((wm >> j) & 1ull) {
            const LAS unsigned char* st = lds + buf * STG;
            const LAS unsigned char* kb = st + hi * 1024 + r32 * 16;
            f32x16 bia0 = f32x16{}, bia1 = f32x16{};
            if (MODE == 1) { const float nsl = -slope2, nref = -m_run[0];
#pragma unroll
                for (int g = 0; g < 4; ++g) {
                    const f32x4 ka = *(const LAS f32x4*)(st + OFF_KPOS + 4 * (8 * g + 4 * hi)), kb4 = *(const LAS f32x4*)(st + OFF_KPOS + 4 * (32 + 8 * g + 4 * hi));
#pragma unroll
                    for (int e = 0; e < 4; ++e) { bia0[4 * g + e] = fma_abs(nsl, pq - ka[e], nref); bia1[4 * g + e] = fma_abs(nsl, pq - kb4[e], nref); } }
            }
#pragma unroll
            for (int mp = 0; mp < NMAP; ++mp) {
                f32x16 p0, p1;
                constexpr int DPM = ND0 / NMAP;
#pragma unroll
                for (int dd = 0; dd < DPM; ++dd) { const int d0 = mp * DPM + dd;
                    const bf16x8 a0 = *(const LAS bf16x8*)(kb + d0 * 2048), a1 = *(const LAS bf16x8*)(kb + d0 * 2048 + 512);
                    if (dd == 0) { const f32x16 c0 = (MODE == 2) ? negm : ((MODE == 1) ? bia0 : f32x16{}), c1 = (MODE == 2) ? negm : ((MODE == 1) ? bia1 : f32x16{}); p0 = __builtin_amdgcn_mfma_f32_32x32x16_bf16(a0, q[d0], c0, 0, 0, 0); p1 = __builtin_amdgcn_mfma_f32_32x32x16_bf16(a1, q[d0], c1, 0, 0, 0); }
                    else { p0 = __builtin_amdgcn_mfma_f32_32x32x16_bf16(a0, q[d0], p0, 0, 0, 0); p1 = __builtin_amdgcn_mfma_f32_32x32x16_bf16(a1, q[d0], p1, 0, 0, 0); } }
                int side = 0;
                if (MODE == 0) {
                    unsigned sto = (unsigned)(uintptr_t)st; asm volatile("" : "+v"(sto)); const LAS unsigned char* stm = (const LAS unsigned char*)(uintptr_t)sto;
                    int lo_t = 0, hi_t = 0;
                    if (MODE == 0) { const int kt0 = u.kbase + 64 * j, qlo = u.i0 + 32 * wrow, bse = kt0 + 4 * hi;
                        const int lo_e = qi - u.radius, hi_e = qi + u.radius;
                        lo_t = (lo_e > 0 ? lo_e : 0) - bse; hi_t = (hi_e < u.n - 1 ? hi_e : u.n - 1) - bse;
                        const int lo_w = qlo + 31 - u.radius, hi_w = qlo + u.radius;
                        const int lo_max = (lo_w > 0 ? lo_w : 0) - kt0, lo_min = ((lo_w - 31) > 0 ? (lo_w - 31) : 0) - kt0 - 4;
                        const int hi_min = (hi_w < u.n - 1 ? hi_w : u.n - 1) - kt0 - 4, hi_max = ((hi_w + 31) < u.n - 1 ? (hi_w + 31) : u.n - 1) - kt0;
                        if (lo_max > 0) side |= (lo_max <= 32) ? 1 : ((lo_min > 27) ? 2 : 3);
                        if (hi_min < 59) side |= (hi_min >= 27) ? 4 : ((hi_max < 32) ? 8 : 12); }
#define ATT_BIAS(MASKEXPR0, MASKEXPR1) _Pragma("unroll") for (int g = 0; g < 4; ++g) { \
                        const f32x4 ka = *(const LAS f32x4*)(stm + OFF_KPOS + 4 * (8 * g + 4 * hi)), kb4 = *(const LAS f32x4*)(stm + OFF_KPOS + 4 * (32 + 8 * g + 4 * hi)); \
                        _Pragma("unroll") for (int e = 0; e < 4; ++e) { const int r = 4 * g + e, c = 8 * g + e; (void)c; \
                            float s0 = p0[r] - slope2 * fabsf(pq - ka[e]), s1 = p1[r] - slope2 * fabsf(pq - kb4[e]); \
                            if (MASKEXPR0) s0 = -1e30f; if (MASKEXPR1) s1 = -1e30f; \
                            p0[r] = s0; p1[r] = s1; } }
                    if (MODE != 0 || side == 0) { ATT_BIAS(false, false) }
                    else if (side == 1) { ATT_BIAS(c < lo_t, false) }
                    else if (side == 2) { ATT_BIAS(true, c + 32 < lo_t) }
                    else if (side == 4) { ATT_BIAS(false, c + 32 > hi_t) }
                    else if (side == 8) { ATT_BIAS(c > hi_t, true) }
                    else { ATT_BIAS(c < lo_t || c > hi_t, c + 32 < lo_t || c + 32 > hi_t) }
#undef ATT_BIAS
                }
                float ra = mx3(p0[0], p0[1], p1[0]), rb = mx3(p0[2], p0[3], p1[1]); ra = mx3(ra, p1[2], p1[3]);
#pragma unroll
                for (int r = 4; r < 16; r += 4) { ra = mx3(ra, p0[r], p0[r + 1]); rb = mx3(rb, p0[r + 2], p0[r + 3]); ra = mx3(ra, p1[r], p1[r + 1]); rb = mx3(rb, p1[r + 2], p1[r + 3]); }
                const float rm = xhalf(fmaxf(ra, rb), false);
                float mr;
                if (MODE == 1) {
                    mlb[mp] = fmaxf(mlb[mp], rm + m_run[0]);
                    if (first || __any(rm > THR)) {
                        const float dl = first ? rm : fmaxf(rm, 0.f); m_run[0] += dl;
#pragma unroll
                        for (int r = 0; r < 16; ++r) { p0[r] -= dl; p1[r] -= dl; }
                        if (mp == 0) {
#pragma unroll
                            for (int r = 0; r < 16; ++r) { bia0[r] -= dl; bia1[r] -= dl; } }
                        if (!first) { const float f = __builtin_amdgcn_exp2f(-dl); l_run[0] *= f; l_run[NMAP - 1] *= f; if (hi == 0) wsf[r32] = f;
                            __builtin_amdgcn_wave_barrier();
#pragma unroll
                            for (int g = 0; g < 4; ++g) { const f32x4 f4 = *(const LAS f32x4*)(wsf + 8 * g + 4 * hi);
#pragma unroll
                                for (int e = 0; e < 4; ++e) { o[0][0][4 * g + e] *= f4[e]; o[0][1][4 * g + e] *= f4[e]; o[NMAP - 1][0][4 * g + e] *= f4[e]; o[NMAP - 1][1][4 * g + e] *= f4[e]; } }
                            __builtin_amdgcn_wave_barrier(); }
                        first = false;
                    }
                    mr = 0.f;
                } else if (MODE == 2) {
                    if (first || __any(rm > THR)) {
                        const float dl = first ? rm : fmaxf(rm, 0.f); m_run[mp] += dl;
#pragma unroll
                        for (int r = 0; r < 16; ++r) { p0[r] -= dl; p1[r] -= dl; negm[r] = -m_run[mp]; }
                        if (!first) { const float f = __builtin_amdgcn_exp2f(-dl); l_run[mp] *= f; if (hi == 0) wsf[r32] = f;
                            __builtin_amdgcn_wave_barrier();
#pragma unroll
                            for (int g = 0; g < 4; ++g) { const f32x4 f4 = *(const LAS f32x4*)(wsf + 8 * g + 4 * hi);
#pragma unroll
                                for (int e = 0; e < 4; ++e) { o[mp][0][4 * g + e] *= f4[e]; o[mp][1][4 * g + e] *= f4[e]; } }
                            __builtin_amdgcn_wave_barrier(); }
                        first = false;
                    }
                    mr = 0.f;
                } else {
                    if (__any(rm > m_run[mp] + THR)) {
                        const float mn = fmaxf(m_run[mp], rm); const float f = __builtin_amdgcn_exp2f(m_run[mp] - mn); l_run[mp] *= f; m_run[mp] = mn; if (hi == 0) wsf[r32] = f;
                        __builtin_amdgcn_wave_barrier();
#pragma unroll
                        for (int g = 0; g < 4; ++g) { const f32x4 f4 = *(const LAS f32x4*)(wsf + 8 * g + 4 * hi);
#pragma unroll
                            for (int e = 0; e < 4; ++e) { o[mp][0][4 * g + e] *= f4[e]; o[mp][1][4 * g + e] *= f4[e]; } }
                        __builtin_amdgcn_wave_barrier();
                    }
                    mr = m_run[mp];
                }
                float s = 0.f;
                if (MODE == 0 && ((side & 3) == 2 || (side & 12) == 8)) {
                    if ((side & 3) == 2) {
#pragma unroll
                        for (int r = 0; r < 16; ++r) { p0[r] = 0.f; p1[r] = __builtin_amdgcn_exp2f(p1[r] - mr); s += p1[r]; } }
                    else {
#pragma unroll
                        for (int r = 0; r < 16; ++r) { p1[r] = 0.f; p0[r] = __builtin_amdgcn_exp2f(p0[r] - mr); s += p0[r]; } }
                } else {
#pragma unroll
                for (int r = 0; r < 16; ++r) { p0[r] = __builtin_amdgcn_exp2f(MODE != 0 ? p0[r] : p0[r] - mr); p1[r] = __builtin_amdgcn_exp2f(MODE != 0 ? p1[r] : p1[r] - mr); s += p0[r] + p1[r]; }
                }
                l_run[mp] += s;
#pragma unroll
                for (int s2 = 0; s2 < 2; ++s2) {
                    u32x4 w; w.x = cvtpk(p0[8 * s2], p0[8 * s2 + 1]); w.y = cvtpk(p0[8 * s2 + 2], p0[8 * s2 + 3]); w.z = cvtpk(p0[8 * s2 + 4], p0[8 * s2 + 5]); w.w = cvtpk(p0[8 * s2 + 6], p0[8 * s2 + 7]); pa[s2] = __builtin_bit_cast(bf16x8, w);
                    u32x4 x; x.x = cvtpk(p1[8 * s2], p1[8 * s2 + 1]); x.y = cvtpk(p1[8 * s2 + 2], p1[8 * s2 + 3]); x.z = cvtpk(p1[8 * s2 + 4], p1[8 * s2 + 5]); x.w = cvtpk(p1[8 * s2 + 6], p1[8 * s2 + 7]); pa[2 + s2] = __builtin_bit_cast(bf16x8, x); }
                if (STAG && late) { pend = true; bprev = buf; }
                else { ATT_PV(st, o[mp]); }
                if (NMAP > 1) __builtin_amdgcn_sched_barrier(0);
            }
        }
        if (!more) break;
        if (!preload) { ATT_STORE(bnext); ATT_SYNC(); }
        j = jn; buf = bnext;
        }
        if (STAG && late && pend) { ATT_PV(lds + bprev * STG, o[0]); pend = false; }
        ATT_SYNC();
    }
#undef ATT_PV
#undef ATT_LOAD
#undef ATT_STORE
#undef ATT_SYNC
    int r32v = r32, hiv = hi, widv = wrow, hhv = hh; asm volatile("" : "+v"(r32v), "+v"(hiv), "+s"(widv), "+s"(hhv));
    float lt[NMAP];
#pragma unroll
    for (int mp = 0; mp < NMAP; ++mp) lt[mp] = xhalf(l_run[mp], true);
    if (MODE == 0 && u.lse && hiv == 0) u.lse[(size_t)(u.r + u.d * (u.i0 + 32 * widv + r32v)) * 4] = m_run[0] + __builtin_amdgcn_logf(lt[0]);
    if (hiv == 0) { wsf[r32v] = 1.f / lt[0]; if (MODE == 1) wsf[32 + r32v] = u.lam / lt[NMAP - 1]; }
    __builtin_amdgcn_wave_barrier();
    float val[2][16];
#pragma unroll
    for (int g = 0; g < 4; ++g) { const f32x4 f4 = *(const LAS f32x4*)(wsf + 8 * g + 4 * hiv); f32x4 h4 = {0.f, 0.f, 0.f, 0.f}; if (MODE == 1) h4 = *(const LAS f32x4*)(wsf + 32 + 8 * g + 4 * hiv);
#pragma unroll
        for (int e = 0; e < 4; ++e) { const int r = 4 * g + e;
#pragma unroll
            for (int dblk = 0; dblk < 2; ++dblk) { float v = o[0][dblk][r] * f4[e]; if (MODE == 1) v -= o[NMAP - 1][dblk][r] * h4[e]; val[dblk][r] = v; } } }
    __builtin_amdgcn_wave_barrier();
    if (MODE == 1) {
        const float g0 = u.gdiff[r32v], g1 = u.gdiff[32 + r32v];
#pragma unroll
        for (int r = 0; r < 16; ++r) { float ss = val[0][r] * val[0][r] + val[1][r] * val[1][r];
            ss += __shfl_xor(ss, 1); ss += __shfl_xor(ss, 2); ss += __shfl_xor(ss, 4); ss += __shfl_xor(ss, 8); ss += __shfl_xor(ss, 16);
            const float rs = rsqrtf(ss * (1.f / 64.f) + RMS_EPS) * u.cscale; val[0][r] *= rs * g0; val[1][r] *= rs * g1; }
    }
#pragma unroll
    for (int r = 0; r < 16; ++r) { const int qr = u.i0 + 32 * widv + (r & 3) + 8 * (r >> 2) + 4 * hiv; const size_t tok = (size_t)(u.r + u.d * qr);
        bf16_t* op_ = u.O + tok * u.op + 64 * hhv + r32v; op_[0] = f2bf(val[0][r]); op_[32] = f2bf(val[1][r]); }
}
}
#include <hip/hip_cooperative_groups.h>
namespace cg = cooperative_groups;
constexpr int NTHREADS = 512, NWAVES = 8;
constexpr int LDS_TOTAL = 131072 + 1024 + 4096 + 1024 + 64;
constexpr int WCONV_SPLIT = 0;
constexpr int KRSPLIT = 1;
constexpr int PJ_DIV = 4;
constexpr int XQUEUE = 1;
constexpr int FUSE_E = 1;
constexpr int NPH = 2 + 8 * DEPTH;
#ifndef MK_EN
#define MK_EN 0xFFFF
#endif
#define EN(b) ((MK_EN >> (b)) & 1)
struct MKArgs { const float* in[23]; float* out; unsigned char* ws; int ph_lo, ph_hi, xmask, ymask; };

#define GAS __attribute__((address_space(1)))
constexpr int CW_KMAX = 8192;
constexpr int CW_BAR = 4096;
constexpr size_t CTL_ZERO_BYTES = 65536 + 8 * 32768;
constexpr int CW_QUEUE = 12288;
constexpr int CW_CNT = 16384;
constexpr int MISC_OFF = 131072;
#define XB_TMO      128
#define XB_XCNT(j)  (256  + 64 * (j))
#define XB_XSUB(j)  (1280 + 64 * (j))
#define XB_XGEN(j)  (2304 + 64 * (j))
#define XB_TOP      3328
#define XB_TOPGEN   3392
#define XCD_BAR_WORDS 3456
#define XB_SPIN_CAP (1u << 18)

__device__ __forceinline__ unsigned xb_ld(unsigned* p)              { return __hip_atomic_load(p, __ATOMIC_RELAXED, __HIP_MEMORY_SCOPE_AGENT); }
__device__ __forceinline__ unsigned xb_add(unsigned* p, unsigned v) { return __hip_atomic_fetch_add(p, v, __ATOMIC_RELAXED, __HIP_MEMORY_SCOPE_AGENT); }
__device__ __forceinline__ unsigned xb_xcc_id() { return (unsigned)__builtin_amdgcn_s_getreg((3 << 11) | 20) & 0xFu; }
#define XB_SPIN(cond, bar) do { unsigned _sp = 0; while (cond) { __builtin_amdgcn_s_sleep(1); \
    if ((++_sp & 255u) == 0u) { if (xb_ld(&(bar)[XB_TMO])) break; if (_sp > XB_SPIN_CAP) { atomicAdd(&(bar)[XB_TMO], 1u); break; } } } } while (0)

struct XcdBarrier {
    unsigned* bar; unsigned x;
    volatile LAS unsigned* st;
};

__device__ __forceinline__ XcdBarrier xcd_barrier_post(unsigned* bar, volatile LAS unsigned* st) {
    XcdBarrier b; b.bar = bar; b.x = xb_xcc_id(); b.st = st;
    if (threadIdx.x == 0) st[3] = xb_add(&bar[XB_XCNT(b.x)], 1u);
    return b;
}
__device__ __forceinline__ void xcd_barrier_complete(unsigned* bar, unsigned x, unsigned& nloc, unsigned& nx, unsigned& uni) {
    const unsigned G = gridDim.x * gridDim.y * gridDim.z;
    unsigned sum, cnt, mine, even, sp = 0u;
    for (;;) {
        sum = 0u; cnt = 0u; mine = 0u; even = 1u;
#pragma unroll
        for (unsigned j = 0; j < 16; ++j) { const unsigned c = xb_ld(&bar[XB_XCNT(j)]); sum += c; cnt += (c > 0u) ? 1u : 0u; mine = (j == x) ? c : mine; even &= (c == (j < 8u ? G / 8u : 0u)) ? 1u : 0u; }
        if (sum == G) break;
        __builtin_amdgcn_s_sleep(1);
        if ((++sp & 255u) == 0u) { if (xb_ld(&bar[XB_TMO])) break; if (sp > XB_SPIN_CAP) { atomicAdd(&bar[XB_TMO], 1u); break; } }
    }
    nloc = mine > 0u ? mine : 1u; nx = cnt > 0u ? cnt : 1u;
    uni = (sum == G && (G & 7u) == 0u && even) ? 1u : 0u;
}

__device__ __forceinline__ void xcd_barrier(const XcdBarrier& b, const int tid_) {
    asm volatile("s_waitcnt vmcnt(0)" ::: "memory");
    __syncthreads();
    if (tid_ == 0) {
        unsigned* bar = b.bar;
        __builtin_amdgcn_s_waitcnt(0);
        unsigned nloc = b.st[0], nx = b.st[1];
        if (nloc == 0u) { unsigned uni; xcd_barrier_complete(bar, b.x, nloc, nx, uni); b.st[0] = nloc; b.st[1] = nx; b.st[2] = uni; }
        const unsigned old = xb_add(&bar[XB_XSUB(b.x)], 1u);
        const unsigned gen = old / nloc;
        if (old + 1u == (gen + 1u) * nloc) {
            __builtin_amdgcn_fence(__ATOMIC_RELEASE, "agent");
            asm volatile("s_waitcnt vmcnt(0)" ::: "memory");
            const unsigned og = xb_add(&bar[XB_TOP], 1u);
            const unsigned tg = og / nx;
            if (og + 1u == (tg + 1u) * nx) xb_add(&bar[XB_TOPGEN], 1u);
            else XB_SPIN(xb_ld(&bar[XB_TOPGEN]) == tg, bar);
            __builtin_amdgcn_fence(__ATOMIC_ACQUIRE, "agent");
            xb_add(&bar[XB_XGEN(b.x)], 1u);
            asm volatile("s_waitcnt vmcnt(0)" ::: "memory");
        } else {
            XB_SPIN(xb_ld(&bar[XB_XGEN(b.x)]) == gen, bar);
            __builtin_amdgcn_fence(__ATOMIC_ACQUIRE, "agent");
            asm volatile("s_waitcnt vmcnt(0)" ::: "memory");
        }
    }
    __syncthreads();
}

constexpr int CW_LBAR = 9216;
__device__ __forceinline__ void xcd_local_barrier(const XcdBarrier& b, unsigned* ctl, const int tid_) {
    asm volatile("s_waitcnt vmcnt(0)" ::: "memory");
    __syncthreads();
    if (tid_ == 0) {
        __builtin_amdgcn_s_waitcnt(0);
        const unsigned nloc = b.st[0];
        unsigned* sub = ctl + CW_LBAR + 64 * b.x; unsigned* gen_ = ctl + CW_LBAR + 1024 + 64 * b.x;
        const unsigned old = xb_add(sub, 1u), gen = old / nloc;
        if (old + 1u == (gen + 1u) * nloc) xb_add(gen_, 1u);
        else XB_SPIN(xb_ld(gen_) == gen, b.bar);
        __builtin_amdgcn_fence(__ATOMIC_ACQUIRE, "agent");
        asm volatile("s_waitcnt vmcnt(0)" ::: "memory");
    }
    __syncthreads();
}
__device__ __forceinline__ float wval(const MKArgs& a, int kind, int l, int k, int n) {
    if (kind == 0) { if (n >= IN_W) return 0.f; float v = a.in[7][((size_t)l * 1024 + k) * IN_W + n];
        if (n < 256 || (n >= ZB_Q && n < ZB_Q + 256)) v *= 0.125f * LOG2E; else if (n >= ZC_Q && n < ZC_Q + 256) v *= 0.17677669529663687f * LOG2E; return v; }
    if (kind == 1) { if (n < 512) return k >= 384 ? a.in[15][l * 128 + (k - 384)] * a.in[17][((size_t)l * 128 + (k - 384)) * 512 + n] : 0.f;
        if (n < 896) return k < 384 ? a.in[14][l * 384 + k] * a.in[16][((size_t)l * 384 + k) * 384 + (n - 512)] * (0.10206207261596575f * LOG2E) : 0.f;
        return 0.f; }
    if (kind == 2) return a.in[18][((size_t)l * 1024 + k) * 1024 + n];
    if (kind == 3) { const int pn = n >> 8, wi = n & 255; const int src = wi < 128 ? pn * 128 + wi : DFF + pn * 128 + (wi - 128); return a.in[21][((size_t)l * 1024 + k) * NGU + src]; }
    return a.in[22][((size_t)l * DFF + k) * 1024 + n];
}
__device__ __forceinline__ void transpose_item(const MKArgs& a, int kind, int l, bf16_t* dst, int K, int k0, int n0, LAS float* scr, int lane) {
#pragma unroll
    for (int i = 0; i < 32; ++i) { const int kk = 2 * i + (lane >> 5); scr[kk * 33 + (lane & 31)] = wval(a, kind, l, k0 + kk, n0 + (lane & 31)); }
    asm volatile("s_waitcnt lgkmcnt(0)" ::: "memory");
    const int c = lane & 7;
#pragma unroll
    for (int j = 0; j < 4; ++j) { const int n = (lane >> 3) + 8 * j; const LAS float* s = scr + (8 * c) * 33 + n;
        u32x4 o; o.x = cvtpk(s[0 * 33], s[1 * 33]); o.y = cvtpk(s[2 * 33], s[3 * 33]); o.z = cvtpk(s[4 * 33], s[5 * 33]); o.w = cvtpk(s[6 * 33], s[7 * 33]);
        *(u32x4*)(dst + (size_t)(n0 + n) * K + k0 + 8 * c) = o; }
    asm volatile("s_waitcnt lgkmcnt(0)" ::: "memory");
}
__device__ __forceinline__ void ph_prologue(const MKArgs& a, LAS unsigned char* lds, int bid, int G, const int tid) {
    const int lane = tid & 63, wid = __builtin_amdgcn_readfirstlane(tid >> 6); (void)lane; (void)wid;
    float* MOD = (float*)(a.ws + WS_MOD);
    for (int it = bid; it < DEPTH * 96; it += G) {
        LAS float* sc_ = (LAS float*)lds;
        LAS float* red = (LAS float*)(lds + 32768);
        const int l = it / 96, cb = it % 96, cl = tid & 63, col = cb * 64 + cl, ks = tid >> 6;
        for (int i = tid; i < 8192; i += NTHREADS) { const int b = i >> 10, k = i & 1023; const float cv = a.in[1][i]; sc_[k * 8 + b] = cv / (1.f + expf(-cv)); }
        __syncthreads();
        float acc[8];
#pragma unroll
        for (int b = 0; b < 8; ++b) acc[b] = 0.f;
        const float* w = a.in[3] + (size_t)l * 1024 * 6144;
#pragma unroll 4
        for (int k = ks * 128; k < ks * 128 + 128; ++k) { const float wv = w[(size_t)k * 6144 + col];
            const f32x4 s0 = *(const LAS f32x4*)(sc_ + k * 8), s1 = *(const LAS f32x4*)(sc_ + k * 8 + 4);
#pragma unroll
            for (int b = 0; b < 4; ++b) { acc[b] += s0[b] * wv; acc[4 + b] += s1[b] * wv; } }
#pragma unroll
        for (int b = 0; b < 8; ++b) red[(ks * 8 + b) * 64 + cl] = acc[b];
        __syncthreads();
        { const int b = tid >> 6; float s = a.in[4][l * 6144 + col];
#pragma unroll
          for (int k2 = 0; k2 < 8; ++k2) s += red[(k2 * 8 + b) * 64 + cl];
          MOD[((size_t)l * 8 + b) * 6144 + col] = s; }
        __syncthreads();
    }
    { float* cosT = (float*)(a.ws + WS_COS); float* sinT = (float*)(a.ws + WS_SIN); const int* pos = (const int*)a.in[2];
      for (int idx = bid * NTHREADS + tid; idx < M * 16; idx += G * NTHREADS) { const int m = idx >> 4, i = idx & 15;
          const float inv = exp2f(-(float)i * (13.287712379549449f / 16.0f)); const float pf = (float)pos[m], ang = pf * inv; cosT[idx] = cosf(ang); sinT[idx] = sinf(ang);
          if (i == 0) ((float*)(a.ws + WS_POSF))[m] = pf; } }
    { float* PMM = (float*)(a.ws + WS_PMM); const int* pos = (const int*)a.in[2];
      for (int t = bid * NTHREADS + tid; t < BATCH * 64; t += G * NTHREADS) { int mn = pos[t * 64], mx = mn; for (int i = 1; i < 64; ++i) { const int p = pos[t * 64 + i]; mn = p < mn ? p : mn; mx = p > mx ? p : mx; } PMM[2 * t] = (float)mn; PMM[2 * t + 1] = (float)mx; } }
}
__device__ __forceinline__ void ph_wconv(const MKArgs& a, LAS unsigned char* lds, int bid, int G, const int tid, const int l0, const int l1) {
    const int lane = tid & 63, wid = __builtin_amdgcn_readfirstlane(tid >> 6);
    LAS float* scr = (LAS float*)(lds + wid * 8448);
    constexpr int I0 = 16 * 88, I1 = 8 * 32, I2 = 16 * 32, I3 = 16 * 176, I4 = 44 * 32, IL = I0 + I1 + I2 + I3 + I4;
    for (int it = l0 * IL + bid * NWAVES + wid; it < l1 * IL; it += G * NWAVES) {
        const int l = it / IL; int r = it % IL; bf16_t* W = (bf16_t*)(a.ws + WS_W + (size_t)l * W_LAYER);
        if (r < I0) { transpose_item(a, 0, l, W + W_IN / 2, 1024, 64 * (r / 88), 32 * (r % 88), scr, lane); continue; } r -= I0;
        if (r < I1) { transpose_item(a, 1, l, W + W_UP / 2, KUP, 64 * (r / 32), 32 * (r % 32), scr, lane); continue; } r -= I1;
        if (r < I2) { transpose_item(a, 2, l, W + W_OUT / 2, 1024, 64 * (r / 32), 32 * (r % 32), scr, lane); continue; } r -= I2;
        if (r < I3) { transpose_item(a, 3, l, W + W_GU / 2, 1024, 64 * (r / 176), 32 * (r % 176), scr, lane); continue; } r -= I3;
        transpose_item(a, 4, l, W + W_DN / 2, DFF, 64 * (r / 32), 32 * (r % 32), scr, lane);
    }
}
__device__ __forceinline__ void ph_elem(const ElemArgs& a, int gw, int ngw, int lane) {
    for (int m = gw; m < M; m += ngw) {
        const int b = m / SEQ; const float* modb = a.modg + (size_t)b * 6144; const float* modnb = a.modn + (size_t)b * 6144;
        f32x4 v[4];
#pragma unroll
        for (int j = 0; j < 4; ++j) v[j] = *(const f32x4*)(a.xin + (size_t)m * DM + 256 * j + 4 * lane);
        if (a.do_res) {
            const f32x4 q0 = *(const f32x4*)(a.YSS + (size_t)m * 16), q1 = *(const f32x4*)(a.YSS + (size_t)m * 16 + 4), q2 = *(const f32x4*)(a.YSS + (size_t)m * 16 + 8), q3 = *(const f32x4*)(a.YSS + (size_t)m * 16 + 12);
            const float ss = (((q0[0] + q0[1]) + (q0[2] + q0[3])) + ((q1[0] + q1[1]) + (q1[2] + q1[3]))) + (((q2[0] + q2[1]) + (q2[2] + q2[3])) + ((q3[0] + q3[1]) + (q3[2] + q3[3])));
            const float rs = rsqrtf(ss * (1.f / DM) + RMS_EPS);
#pragma unroll
            for (int j = 0; j < 4; ++j) { const int c0 = 256 * j + 4 * lane;
                const uint2 yy = *(const uint2*)(a.Y + (size_t)m * DM + c0);
                const float y0 = __uint_as_float(yy.x << 16), y1 = __uint_as_float(yy.x & 0xffff0000u), y2 = __uint_as_float(yy.y << 16), y3 = __uint_as_float(yy.y & 0xffff0000u);
                const f32x4 gp = *(const f32x4*)(a.gpost + c0), gt = *(const f32x4*)(modb + a.gate_chunk * 1024 + c0);
                v[j][0] += gt[0] * (y0 * rs * gp[0]); v[j][1] += gt[1] * (y1 * rs * gp[1]); v[j][2] += gt[2] * (y2 * rs * gp[2]); v[j][3] += gt[3] * (y3 * rs * gp[3]); }
#pragma unroll
            for (int j = 0; j < 4; ++j) *(f32x4*)(a.xout + (size_t)m * DM + 256 * j + 4 * lane) = v[j];
        }
        if (a.do_norm) {
            float s = 0.f;
#pragma unroll
            for (int j = 0; j < 4; ++j) s += (v[j][0] * v[j][0] + v[j][1] * v[j][1]) + (v[j][2] * v[j][2] + v[j][3] * v[j][3]);
            const float rs = rsqrtf(wave_sum(s) * (1.f / DM) + RMS_EPS);
#pragma unroll
            for (int j = 0; j < 4; ++j) { const int c0 = 256 * j + 4 * lane;
                const f32x4 g = *(const f32x4*)(a.gpre + c0), sc = *(const f32x4*)(modnb + a.sc_chunk * 1024 + c0), sh = *(const f32x4*)(modnb + a.sh_chunk * 1024 + c0);
                float o[4];
#pragma unroll
                for (int e = 0; e < 4; ++e) o[e] = v[j][e] * rs * g[e] * (1.f + sc[e]) + sh[e];
                uint2 w; w.x = cvtpk(o[0], o[1]); w.y = cvtpk(o[2], o[3]);
                *(uint2*)(a.XN + (size_t)m * DM + c0) = w; }
        }
    }
}
__device__ __forceinline__ void ph_elem0(const ElemArgs& a, int gw, int ngw, int lane) {
    f32x4 v[4], v1[4], v2[4];
#pragma unroll
    for (int j = 0; j < 4; ++j) { v[j] = (f32x4){0.f, 0.f, 0.f, 0.f}; v1[j] = v[j]; v2[j] = v[j]; }
    if (gw < M) {
#pragma unroll
        for (int j = 0; j < 4; ++j) v[j] = *(const f32x4*)(a.xin + (size_t)gw * DM + 256 * j + 4 * lane); }
    if (gw + ngw < M) {
#pragma unroll
        for (int j = 0; j < 4; ++j) v1[j] = *(const f32x4*)(a.xin + (size_t)(gw + ngw) * DM + 256 * j + 4 * lane); }
#pragma unroll 1
    for (int m = gw; m < M; m += ngw) {
        const int m2 = m + 2 * ngw;
        if (m2 < M) {
#pragma unroll
            for (int j = 0; j < 4; ++j) v2[j] = *(const f32x4*)(a.xin + (size_t)m2 * DM + 256 * j + 4 * lane); }
        const int b = m / SEQ; const float* modnb = a.modn + (size_t)b * 6144;
        float s = 0.f;
#pragma unroll
        for (int j = 0; j < 4; ++j) s += (v[j][0] * v[j][0] + v[j][1] * v[j][1]) + (v[j][2] * v[j][2] + v[j][3] * v[j][3]);
        const float rs = rsqrtf(wave_sum(s) * (1.f / DM) + RMS_EPS);
#pragma unroll
        for (int j = 0; j < 4; ++j) { const int c0 = 256 * j + 4 * lane;
            const f32x4 g = *(const f32x4*)(a.gpre + c0), sc = *(const f32x4*)(modnb + a.sc_chunk * 1024 + c0), sh = *(const f32x4*)(modnb + a.sh_chunk * 1024 + c0);
            float o[4];
#pragma unroll
            for (int e = 0; e < 4; ++e) o[e] = v[j][e] * rs * g[e] * (1.f + sc[e]) + sh[e];
            uint2 w; w.x = cvtpk(o[0], o[1]); w.y = cvtpk(o[2], o[3]);
            *(uint2*)(a.XN + (size_t)m * DM + c0) = w; }
#pragma unroll
        for (int j = 0; j < 4; ++j) { v[j] = v1[j]; v1[j] = v2[j]; }
    }
}
__device__ __forceinline__ void unit_common(att::Unit& u, const MKArgs& a, int b) { u.posf = (const float*)(a.ws + WS_POSF) + (size_t)b * SEQ; u.K2 = nullptr; u.k2p = 0; u.lse = nullptr; u.lam = 0.f; u.cscale = 1.f; u.gdiff = nullptr; u.pmm = nullptr; u.kn0 = 0.f; u.kn1 = 0.f; u.hsplit = 0; u.slope2b = 0.f; u.m_initb = 0.f; u.r = 0; u.d = 1; u.n = SEQ; u.radius = 0; }
__device__ __forceinline__ void run_unit_a(const MKArgs& a, LAS unsigned char* lds, int br, int ua, const int tid) {
    const bf16_t* Z = (const bf16_t*)(a.ws + WS_ZH); bf16_t* OA = (bf16_t*)(a.ws + WS_Y); float* LSE = (float*)(a.ws + WS_LSE);
    const int bh = ua >> 4, sub = ua & 15, b = bh >> 2, h = bh & 3, d = br == 0 ? 1 : (br == 1 ? 4 : 16);
    att::Unit u; unit_common(u, a, b);
    u.d = d; u.n = SEQ / d; u.r = br == 0 ? 0 : (br == 1 ? (sub >> 2) : sub); const int qblk = br == 0 ? sub : (br == 1 ? (sub & 3) : 0);
    u.i0 = 256 * qblk; u.radius = 64; u.kbase = u.i0 - 64; u.ntiles = 6;
    const bf16_t* Zb = Z + (size_t)b * SEQ * NZ;
    u.Q = Zb + ZA_Q + 64 * h; u.qp = NZ; u.K1 = Zb + ZA_K + 64 * h; u.k1p = NZ; u.V = Zb + ZA_V + 64 * h; u.vp = NZ;
    u.slope2 = alibi_slope(9 + h) * LOG2E; u.m_init = -1e20f; u.l_init = 0.f;
    u.O = OA + ((size_t)br * M + (size_t)b * SEQ) * 256 + 64 * h; u.op = 256; u.lse = LSE + ((size_t)br * M + (size_t)b * SEQ) * 4 + h;
    att::attn_unit<0>(u, lds, tid);
}
__device__ __forceinline__ void run_unit_b(const MKArgs& a, LAS unsigned char* lds, int l, int ub, const int tid) {
    const bf16_t* Z = (const bf16_t*)(a.ws + WS_ZH); bf16_t* MIX = (bf16_t*)(a.ws + WS_MIX);
    const int bg = ub >> 5, qblk = ub & 31, b = bg >> 1, g = bg & 1, h = 2 * g;
    att::Unit u; unit_common(u, a, b);
    u.i0 = 128 * qblk; u.radius = 128; u.kbase = u.i0 - 128; u.ntiles = 6; u.hsplit = 1;
    const bf16_t* Zb = Z + (size_t)b * SEQ * NZ;
    u.Q = Zb + ZB_Q + 64 * h; u.qp = NZ; u.K1 = Zb + ZB_K + 64 * g; u.k1p = NZ; u.V = Zb + ZB_V + 64 * g; u.vp = NZ;
    u.slope2 = alibi_slope(1 + h) * LOG2E; u.m_init = a.in[8][l * 4 + h] * LOG2E; u.l_init = 1.f;
    u.slope2b = alibi_slope(2 + h) * LOG2E; u.m_initb = a.in[8][l * 4 + h + 1] * LOG2E;
    u.O = MIX + (size_t)b * SEQ * DM + 256 + 64 * h; u.op = DM;
    att::attn_unit<0>(u, lds, tid);
}
__device__ __forceinline__ void run_unit_c(const MKArgs& a, LAS unsigned char* lds, int l, int uc, const int tid) {
    const bf16_t* Z = (const bf16_t*)(a.ws + WS_ZH); bf16_t* MIX = (bf16_t*)(a.ws + WS_MIX);
    const int bh = uc >> 4, qblk = uc & 15, b = bh >> 2, h = bh & 3;
    att::Unit u; unit_common(u, a, b);
    u.i0 = 256 * qblk; u.kbase = 0; u.ntiles = SEQ / 64;
    const bf16_t* Zb = Z + (size_t)b * SEQ * NZ;
    u.Q = Zb + ZC_Q + 64 * h; u.qp = NZ; u.K1 = Zb + ZC_K + 64 * h; u.k1p = NZ; u.V = Zb + ZC_V + 64 * h; u.vp = NZ;
    u.slope2 = alibi_slope(5 + h) * LOG2E; u.m_init = -1e20f; u.l_init = 0.f;
    const int li_ = tid & 31;
    const float d1 = wave_sum(a.in[9][l * 32 + li_] * a.in[10][l * 32 + li_]) * 0.5f, d2 = wave_sum(a.in[11][l * 32 + li_] * a.in[12][l * 32 + li_]) * 0.5f;
    const float lam_init = 0.8f - 0.6f * expf(-0.3f * (float)l);
    u.lam = expf(d1) - expf(d2) + lam_init; u.cscale = 1.f - lam_init; u.gdiff = a.in[13] + l * 64;
    u.O = MIX + (size_t)b * SEQ * DM + 512 + 64 * h; u.op = DM;
    { const unsigned* KMAX = (const unsigned*)(a.ws + WS_CTL) + CW_KMAX + (b * 4 + h) * 2; u.pmm = (const float*)(a.ws + WS_PMM) + (size_t)b * 128;
      u.kn0 = sqrtf(__uint_as_float(KMAX[0])) * 1.02f; u.kn1 = sqrtf(__uint_as_float(KMAX[1])) * 1.02f; }
    att::attn_unit<1>(u, lds, tid);
}
__device__ __forceinline__ void run_unit_d(const MKArgs& a, LAS unsigned char* lds, int ud, const int tid) {
    const bf16_t* Z = (const bf16_t*)(a.ws + WS_ZH); bf16_t* MIX = (bf16_t*)(a.ws + WS_MIX); const bf16_t* KV = (const bf16_t*)(a.ws + WS_KV); const bf16_t* QD = (const bf16_t*)(a.ws + WS_QD);
    const int bh = ud >> 4, qblk = ud & 15, b = bh >> 2, h = bh & 3;
    att::Unit u; unit_common(u, a, b);
    u.i0 = 256 * qblk; u.kbase = 0; u.ntiles = SEQ / 64;
    const size_t rb = (size_t)b * SEQ;
    u.Q = QD + rb * 384 + 96 * h; u.qp = 384; u.K1 = KV + rb * 512 + 128 * h; u.k1p = 512; u.K2 = Z + rb * NZ + ZD_KR; u.k2p = NZ; u.V = KV + rb * 512 + 128 * h + 64; u.vp = 512;
    u.slope2 = 0.f; u.m_init = -1e20f; u.l_init = 0.f;
    u.O = MIX + rb * DM + 768 + 64 * h; u.op = DM;
    att::attn_unit<2>(u, lds, tid);
}
__device__ __forceinline__ void ph_merge_a(const MKArgs& a, int gtid, int gthreads, int b) {
    const bf16_t* OA = (const bf16_t*)(a.ws + WS_Y); const float* LSE = (const float*)(a.ws + WS_LSE); bf16_t* MIX = (bf16_t*)(a.ws + WS_MIX);
    for (int idx = gtid; idx < SEQ * 32; idx += gthreads) { const size_t row = (size_t)b * SEQ + (idx >> 5); const int ch = idx & 31, h = ch >> 3;
        const float l0 = LSE[row * 4 + h], l1 = LSE[((size_t)M + row) * 4 + h], l2 = LSE[((size_t)2 * M + row) * 4 + h];
        const float mx = fmaxf(l0, fmaxf(l1, l2)); float w0 = exp2f(l0 - mx), w1 = exp2f(l1 - mx), w2 = exp2f(l2 - mx); const float inv = 1.f / (w0 + w1 + w2); w0 *= inv; w1 *= inv; w2 *= inv;
        const u32x4 x0 = *(const u32x4*)(OA + row * 256 + 8 * ch), x1 = *(const u32x4*)(OA + ((size_t)M + row) * 256 + 8 * ch), x2 = *(const u32x4*)(OA + ((size_t)2 * M + row) * 256 + 8 * ch);
        u32x4 o;
#pragma unroll
        for (int e = 0; e < 4; ++e) { const float lo = w0 * __uint_as_float(x0[e] << 16) + w1 * __uint_as_float(x1[e] << 16) + w2 * __uint_as_float(x2[e] << 16);
            const float hi = w0 * __uint_as_float(x0[e] & 0xffff0000u) + w1 * __uint_as_float(x1[e] & 0xffff0000u) + w2 * __uint_as_float(x2[e] & 0xffff0000u); o[e] = cvtpk(lo, hi); }
        *(u32x4*)(MIX + row * DM + 8 * ch) = o; }
}

__global__ void __launch_bounds__(NTHREADS, 2) mk_fwd(MKArgs a) {
    extern __shared__ __attribute__((aligned(16))) unsigned char lds_raw[];
    LAS unsigned char* lds = (LAS unsigned char*)lds_raw;
    const int wid0 = __builtin_amdgcn_readfirstlane((int)(threadIdx.x >> 6));
    const int G = gridDim.x, bid = blockIdx.x, vcu = (G % 8 == 0) ? (bid % 8) * (G / 8) + bid / 8 : bid;
    unsigned char* ws = a.ws;
    float* MOD = (float*)(ws + WS_MOD); float* COS = (float*)(ws + WS_COS); float* SIN = (float*)(ws + WS_SIN); float* SS = (float*)(ws + WS_SS); float* YSS = (float*)(ws + WS_YSS);
    bf16_t* XN = (bf16_t*)(ws + WS_XN); bf16_t* ZH = (bf16_t*)(ws + WS_ZH); bf16_t* KV = (bf16_t*)(ws + WS_KV); bf16_t* QD = (bf16_t*)(ws + WS_QD); bf16_t* MIX = (bf16_t*)(ws + WS_MIX); bf16_t* Y = (bf16_t*)(ws + WS_Y);
    const float* x = a.in[0]; float* out = a.out;
    const int ngw = G * NWAVES;
    volatile LAS unsigned* MISC = (volatile LAS unsigned*)(lds + MISC_OFF);
    for (int u = threadIdx.x; u < 64; u += NTHREADS) MISC[u] = 0u;
    __syncthreads();
    XcdBarrier bar; bar.bar = (unsigned*)(ws + WS_CTL) + CW_BAR; bar.x = 0; bar.st = nullptr;
    if (a.ph_hi - a.ph_lo > 1) bar = xcd_barrier_post((unsigned*)(ws + WS_CTL) + CW_BAR, MISC + 8);
    for (int ph = a.ph_lo; ph < a.ph_hi; ++ph) {
        int tid; asm volatile("v_mbcnt_lo_u32_b32 %0, -1, 0\n\tv_mbcnt_hi_u32_b32 %0, -1, %0" : "=v"(tid)); tid += wid0 * 64;
        const int lane = tid & 63, wid = __builtin_amdgcn_readfirstlane(tid >> 6), gw = vcu * NWAVES + wid;
        if (ph == 0) { if (EN(8)) ph_prologue(a, lds, bid, G, tid); }
        else if (ph == 1) { if (EN(9)) { ElemArgs e{x, out, nullptr, nullptr, nullptr, MOD, 0, a.in[5], MOD, 1, 0, XN, 0, 1}; ph_elem0(e, gw, ngw, lane); ph_wconv(a, lds, bid, G, tid, 0, (WCONV_SPLIT && G == 256) ? 1 : DEPTH); } }
        else {
            const int l = (ph - 2) >> 3, st = (ph - 2) & 7;
            const bool loc = __builtin_amdgcn_readfirstlane((int)MISC[10]) != 0;
            const int vb = loc ? __builtin_amdgcn_readfirstlane((int)MISC[11]) * 8 + (int)bar.x : bid, vcu = (G % 8 == 0) ? (vb % 8) * (G / 8) + vb / 8 : vb;
            if (FUSE_E && (st == 4 || st == 7)) continue;
            const int xmask = a.xmask, ymask = a.ymask;
            const bf16_t* W = (const bf16_t*)(ws + WS_W + (size_t)l * W_LAYER); const float* modl = MOD + (size_t)l * 8 * 6144;
            pg8::StaticOrder S;
            const bool pjq = XQUEUE && a.xmask == 15 && (G & 7) == 0 && (G / 8) % PJ_DIV == 0, pjrole = !pjq || ((vb >> 3) % PJ_DIV == 0);
            const int pjG = pjq ? G / PJ_DIV : G, pjc = pjq ? ((vb >> 3) / PJ_DIV) * 8 + (vb & 7) : vb;
            if (st == 0 || (KRSPLIT && st == 1 && (xmask & 1) && pjrole)) { if (EN(0)) { const bool kr = (st == 1);
                pg8::Gemm g{XN, W + W_IN / 2 + (kr ? (size_t)2560 * DM : (size_t)0), M, KRSPLIT ? (kr ? 256 : 2560) : NZ, DM, DM, 0}; S.init(M, g.N, kr ? pjG : G, kr ? pjc : vb); EpiZ E{ZH, SS, COS, SIN, (unsigned*)(ws + WS_CTL) + CW_KMAX, kr ? 10 : 0}; pg8::gemm_phase<EpiZ, true>(lds, g, S, E, tid);
                if (WCONV_SPLIT && l == 0 && G == 256 && bid >= 128) ph_wconv(a, lds, bid - 128, 128, tid, 1, DEPTH); } }
            if (st == 1) {
                if (EN(1) && (xmask & 1) && pjrole) { pg8::Gemm g{ZH + ZD_CQ, W + W_UP / 2, M, NUP, KUP, NZ, 1}; S.init(M, NUP, pjG, pjc); EpiUp E{KV, QD, SS, COS, SIN}; pg8::gemm_phase<EpiUp, true>(lds, g, S, E, tid); }
                if (XQUEUE && xmask == 15 && (G & 7) == 0) {
                    const int qx = vb & 7, b = qx; unsigned* ctr = (unsigned*)(ws + WS_CTL) + CW_QUEUE + (l * 8 + qx) * 64;
                    unsigned nreg = 0u; if (tid == 0) nreg = atomicAdd(ctr, 1u);
                    if (tid == 0) MISC[16] = nreg;
                    __syncthreads(); int it = (int)MISC[16]; __syncthreads();
                    while (it < 320) {
                        if (tid == 0) nreg = atomicAdd(ctr, 1u);
                        if (it < 64) { const int h = 3 - (it >> 4), qb = it & 15; run_unit_c(a, lds, l, ((b * 4 + h) << 4) + qb, tid); }
                        else if (it < 128) { const int j = it - 64; run_unit_b(a, lds, l, ((b * 2 + (j >> 5)) << 5) + (j & 31), tid); }
                        else { const int j = it - 128, br = j >> 6, rem = j & 63; run_unit_a(a, lds, br, ((b * 4 + (rem >> 4)) << 4) + (rem & 15), tid); }
                        if (tid == 0) MISC[16] = nreg;
                        __syncthreads(); it = (int)MISC[16]; __syncthreads();
                    }
                } else {
                if (EN(12) && (xmask & 8)) for (int u = vcu; u < 512; u += G) run_unit_c(a, lds, l, u < 256 ? u : (u ^ 48), tid);
                if (EN(11) && (xmask & 4)) for (int u = vcu; u < 512; u += G) run_unit_b(a, lds, l, u, tid);
                if (EN(10) && (xmask & 2)) for (int br = 0; br < 3; ++br) for (int u = vcu; u < 512; u += G) run_unit_a(a, lds, br, u, tid);
                }
            }
            else if (st == 2) {
                if ((G & 7) == 0) {
                    const int db = vb & 7, dr = vb >> 3, gsz = G >> 3;
                    const int nu = dr < 64 ? (64 - dr + gsz - 1) / gsz : 0, mpos = (vb % 3) < nu ? (vb % 3) : nu;
                    for (int k = 0; k <= nu; ++k) {
                        if (k == mpos && EN(13) && (ymask & 2)) ph_merge_a(a, dr * NTHREADS + tid, gsz * NTHREADS, db);
                        if (k < nu && EN(2) && (ymask & 1)) run_unit_d(a, lds, (db << 6) + dr + k * gsz, tid); }
                } else {
                    const int nu = vcu < 512 ? (512 - vcu + G - 1) / G : 0;
                    for (int k = 0; k < nu; ++k) if (EN(2) && (ymask & 1)) run_unit_d(a, lds, vcu + k * G, tid);
                    if (EN(13) && (ymask & 2)) for (int b2 = 0; b2 < BATCH; ++b2) ph_merge_a(a, vcu * NTHREADS + tid, G * NTHREADS, b2);
                }
            }
            else if (st == 3) { if (EN(3)) { pg8::Gemm g{MIX, W + W_OUT / 2, M, DM, DM, DM, 0}; S.init(M, DM, G, vb);
                if (FUSE_E) { unsigned* cnt = (unsigned*)(ws + WS_CTL) + CW_CNT + (l * 4) * 8192; unsigned* slot = (unsigned*)YSS;
                    EpiFused E{l == 0 ? x : out, out, XN, a.in[6] + l * DM, modl, 2, a.in[19] + l * DM, modl, 4, 3, RowStat{slot, cnt}, RowStat{slot + (size_t)M * 4, cnt + 8192}, 1};
                    pg8::gemm_phase<EpiFused, true>(lds, g, S, E, tid); }
                else { EpiY E{Y, YSS}; pg8::gemm_phase<EpiY, true>(lds, g, S, E, tid); } } }
            else if (st == 4) { ElemArgs e{l == 0 ? x : out, out, Y, YSS, a.in[6] + l * DM, modl, 2, a.in[19] + l * DM, modl, 4, 3, XN, 1, 1}; ph_elem(e, gw, ngw, lane); }
            else if (st == 5) { if (EN(5)) { pg8::Gemm g{XN, W + W_GU / 2, M, NGU, DM, DM, 0}; S.init(M, NGU, G, vb); EpiH E{ZH}; pg8::gemm_phase<EpiH, true>(lds, g, S, E, tid); } }
            else if (st == 6) { if (EN(6)) { pg8::Gemm g{ZH, W + W_DN / 2, M, DM, DFF, DFF, 0}; S.init(M, DM, G, vb);
                if (FUSE_E) { const int ln = l + 1 < DEPTH ? l + 1 : l; unsigned* cnt = (unsigned*)(ws + WS_CTL) + CW_CNT + (l * 4 + 2) * 8192; unsigned* slot = (unsigned*)YSS;
                    EpiFused E{out, out, XN, a.in[20] + l * DM, modl, 5, a.in[5] + ln * DM, MOD + (size_t)ln * 8 * 6144, 1, 0, RowStat{slot, cnt}, RowStat{slot + (size_t)M * 4, cnt + 8192}, l + 1 < DEPTH ? 1 : 0};
                    pg8::gemm_phase<EpiFused, true>(lds, g, S, E, tid); }
                else { EpiY E{Y, YSS}; pg8::gemm_phase<EpiY, true>(lds, g, S, E, tid); } } }
            else if (st == 7) { const int ln = l + 1 < DEPTH ? l + 1 : l;
                ElemArgs e{out, out, Y, YSS, a.in[20] + l * DM, modl, 5, a.in[5] + ln * DM, MOD + (size_t)ln * 8 * 6144, 1, 0, XN, 1, l + 1 < DEPTH ? 1 : 0}; ph_elem(e, gw, ngw, lane); }
        }
        if (ph + 1 < a.ph_hi && !(FUSE_E && ph == NPH - 2)) { if (a.ph_lo < 0) cg::this_grid().sync(); else { int tb; asm volatile("v_mbcnt_lo_u32_b32 %0, -1, 0\n\tv_mbcnt_hi_u32_b32 %0, -1, %0" : "=v"(tb)); tb += wid0 * 64;
            if (ph >= 2 && __builtin_amdgcn_readfirstlane((int)MISC[10]) != 0) xcd_local_barrier(bar, (unsigned*)(ws + WS_CTL), tb); else xcd_barrier(bar, tb); } }
    }
}
extern "C" void kernel_launch(void* const* d_in, const int* in_sizes, int n_in, void* d_out, int out_size, void* d_ws, size_t ws_size, hipStream_t stream) {
    if (n_in != 23 || out_size != M * DM || ws_size < WS_END) { fprintf(stderr, "kernel_launch: unexpected shapes (n_in %d out %d ws %zu)\n", n_in, out_size, ws_size); return; }
    static int grid = 0;
    if (grid == 0) {
        int dev = 0, cus = 0, per_cu = 0;
        hipGetDevice(&dev); hipDeviceGetAttribute(&cus, hipDeviceAttributeMultiprocessorCount, dev);
        if (hipFuncSetAttribute((const void*)mk_fwd, hipFuncAttributeMaxDynamicSharedMemorySize, LDS_TOTAL) != hipSuccess) { fprintf(stderr, "kernel_launch: hipFuncSetAttribute failed\n"); grid = -1; return; }
        if (hipOccupancyMaxActiveBlocksPerMultiprocessor(&per_cu, (const void*)mk_fwd, NTHREADS, LDS_TOTAL) != hipSuccess || per_cu < 1) { fprintf(stderr, "kernel_launch: occupancy query says %d\n", per_cu); per_cu = 1; }
        (void)hipGetLastError();
        grid = cus * 1;
    }
    if (grid < 0) return;
    unsigned char* ws = (unsigned char*)d_ws; float* out = (float*)d_out;
    MKArgs a{};
    for (int i = 0; i < 23; ++i) a.in[i] = (const float*)d_in[i];
    a.out = out; a.ws = ws; a.xmask = 15; a.ymask = 3;
    if (hipMemsetAsync(ws + WS_CTL, 0, CTL_ZERO_BYTES, stream) != hipSuccess) { fprintf(stderr, "kernel_launch: memset failed\n"); return; }
    {
        a.ph_lo = 0; a.ph_hi = NPH; void* args[] = {&a};
        hipError_t e = hipLaunchCooperativeKernel((const void*)mk_fwd, dim3(grid), dim3(NTHREADS), args, LDS_TOTAL, stream);
        if (e != hipSuccess) fprintf(stderr, "cooperative launch failed: %s (grid %d)\n", hipGetErrorString(e), grid);
        return;
    }
}
```
